# Optimizing an MI355X kernel written in HIP

```python
import jax, jax.numpy as jnp
from jax import lax
import numpy as np

D_MODEL = 2048
BATCH = 8
SEQ = 2048
DEPTH = 1

D_MIX = D_MODEL
D_A = D_MIX // 2
D_B = D_MIX - D_A
HEAD_A = 128
N_HEADS_A = D_A // HEAD_A
GMLP_CHUNK = 128
HEAD_B_V = 128
N_HEADS_B = D_B // HEAD_B_V
HEAD_B_K = 128
F_B = N_HEADS_B * HEAD_B_K
SCAN_CHUNK = 64
IN_COLS = 2 * D_A + 3 * F_B + 2 * D_B
N_EXPERTS = 32
TOP_K = 4
D_EXPERT = D_MODEL
SWIGLU_LIMIT = 7.0
SWIGLU_ALPHA = 1.702
MOE_BLOCK = 512
EPS = 1e-5

kernel_name = "hybrid_gmlp_hgrn2_moe_encoder"


def rmsnorm(x, w):
    xf = x.astype(jnp.float32)
    xf = xf * lax.rsqrt(jnp.mean(xf * xf, axis=-1, keepdims=True) + EPS)
    return xf.astype(x.dtype) * w


def layernorm(x, w, b):
    xf = x.astype(jnp.float32)
    mu = jnp.mean(xf, axis=-1, keepdims=True)
    var = jnp.mean(jnp.square(xf - mu), axis=-1, keepdims=True)
    return ((xf - mu) * lax.rsqrt(var + EPS)).astype(x.dtype) * w + b


def gmlp_mixer(u, v, ln_w, ln_b, w_s, b_s):
    B, S, _ = v.shape
    nc = S // GMLP_CHUNK
    v = layernorm(v, ln_w, ln_b)
    vh = v.reshape(B, nc, GMLP_CHUNK, N_HEADS_A, HEAD_A)
    mixed = jnp.einsum('hts,bcshd->bcthd', w_s, vh) + b_s.T[None, None, :, :, None]
    return u * mixed.reshape(B, S, D_A)


def gla_chunked(q, k, v, log_f):
    B, S, H, K = q.shape
    V = v.shape[-1]
    C = SCAN_CHUNK
    nc = S // C

    def to_chunks(t):
        return t.astype(jnp.float32).reshape(B, nc, C, H, t.shape[-1]).transpose(1, 0, 3, 2, 4)

    qc, kc, vc, gc = to_chunks(q), to_chunks(k), to_chunks(v), to_chunks(log_f)
    cum = jnp.cumsum(gc, axis=3)
    cum_last = cum[:, :, :, -1:, :]
    q_dec = qc * jnp.exp(cum)
    k_dec = kc * jnp.exp(-cum)
    k_tail = kc * jnp.exp(cum_last - cum)
    mask = jnp.tril(jnp.ones((C, C), dtype=bool))
    scores = jnp.where(mask, jnp.einsum('nbhtk,nbhsk->nbhts', q_dec, k_dec), 0.0)
    o_intra = jnp.einsum('nbhts,nbhsv->nbhtv', scores, vc)
    d_state = jnp.einsum('nbhsk,nbhsv->nbhkv', k_tail, vc)
    decay = jnp.exp(cum_last[:, :, :, 0, :])

    def step(s_prev, inp):
        d, ds = inp
        return d[..., None] * s_prev + ds, s_prev

    s0 = jnp.zeros((B, H, K, V), jnp.float32)
    _, s_before = lax.scan(step, s0, (decay, d_state))
    o = o_intra + jnp.einsum('nbhtk,nbhkv->nbhtv', q_dec, s_before)
    return o.transpose(1, 0, 3, 2, 4).reshape(B, S, H, V)


def lower_bound(table, layer):
    return jnp.cumsum(jax.nn.softmax(table.astype(jnp.float32), axis=0), axis=0)[layer]


def hgrn2_mixer(q_raw, ff_raw, fb_raw, i_raw, g_raw, lb_f, lb_b, norm_w):
    B, S, _ = q_raw.shape
    q = jax.nn.silu(q_raw).reshape(B, S, N_HEADS_B, HEAD_B_K)
    i = i_raw.reshape(B, S, N_HEADS_B, HEAD_B_V)

    def gates(f_raw, lb):
        lb = lb.reshape(N_HEADS_B, HEAD_B_K)
        f = lb + (1.0 - lb) * jax.nn.sigmoid(f_raw.astype(jnp.float32).reshape(B, S, N_HEADS_B, HEAD_B_K))
        return 1.0 - f, jnp.log(f)

    k_f, logf_f = gates(ff_raw, lb_f)
    k_b, logf_b = gates(fb_raw, lb_b)
    o_fwd = gla_chunked(q, k_f, i, logf_f)
    flip = lambda t: jnp.flip(t, axis=1)
    o_bwd = flip(gla_chunked(flip(q), flip(k_b), flip(i), flip(logf_b)))
    o = o_fwd + o_bwd
    o = o * lax.rsqrt(jnp.mean(o * o, axis=-1, keepdims=True) + EPS)
    g = jax.nn.silu(g_raw.astype(jnp.float32)).reshape(B, S, N_HEADS_B, HEAD_B_V)
    o = o.astype(q_raw.dtype) * norm_w * g.astype(q_raw.dtype)
    return o.reshape(B, S, D_B)


def moe(x2d, w_router, b_router, w1, b1, w2, b2):
    N, D = x2d.shape
    logits = (x2d @ w_router + b_router).astype(jnp.float32)
    top_vals, top_idx = lax.top_k(logits, TOP_K)
    gates = jax.nn.softmax(top_vals, axis=-1)
    A = N * TOP_K
    flat_e = top_idx.reshape(A)
    flat_tok = jnp.arange(A, dtype=jnp.int32) // TOP_K
    flat_g = gates.reshape(A)
    order = jnp.argsort(flat_e)
    sorted_e = flat_e[order]
    counts = jnp.bincount(flat_e, length=N_EXPERTS)
    padded = (counts + MOE_BLOCK - 1) // MOE_BLOCK * MOE_BLOCK
    start_sorted = jnp.cumsum(counts) - counts
    pad_end = jnp.cumsum(padded)
    start_pad = pad_end - padded
    dest = start_pad[sorted_e] + (jnp.arange(A, dtype=jnp.int32) - start_sorted[sorted_e])
    n_blocks = -(-A // MOE_BLOCK) + N_EXPERTS
    P = n_blocks * MOE_BLOCK
    row_tok = jnp.zeros((P,), jnp.int32).at[dest].set(flat_tok[order])
    row_gate = jnp.zeros((P,), jnp.float32).at[dest].set(flat_g[order])
    block_start = jnp.arange(n_blocks, dtype=jnp.int32) * MOE_BLOCK
    block_e = jnp.minimum(jnp.searchsorted(pad_end, block_start, side='right'), N_EXPERTS - 1)

    def run_block(args):
        e, toks, g = args
        h = x2d[toks] @ w1[e] + b1[e]
        x_glu = jnp.minimum(h[:, ::2], SWIGLU_LIMIT)
        x_lin = jnp.clip(h[:, 1::2], -SWIGLU_LIMIT, SWIGLU_LIMIT)
        act = x_glu * jax.nn.sigmoid(SWIGLU_ALPHA * x_glu) * (x_lin + 1.0)
        y = act @ w2[e] + b2[e]
        return y * g[:, None].astype(y.dtype)

    y = lax.map(run_block, (block_e, row_tok.reshape(n_blocks, MOE_BLOCK),
                            row_gate.reshape(n_blocks, MOE_BLOCK)))
    return jax.ops.segment_sum(y.reshape(P, D), row_tok, num_segments=N)


def setup_inputs(seed: int = 0) -> dict:
    key = jax.random.key(seed)
    ks = jax.random.split(key, 24)
    f32 = jnp.float32
    nrm = lambda k, shape, scale: jax.random.normal(k, shape, f32) * scale
    gain = lambda k, shape: 1.0 + 0.02 * jax.random.normal(k, shape, f32)
    return {
        "x": nrm(ks[0], (BATCH, SEQ, D_MODEL), 1.0),
        "mix_norm": gain(ks[1], (DEPTH, D_MODEL)),
        "w_in": nrm(ks[2], (DEPTH, D_MODEL, IN_COLS), D_MODEL ** -0.5),
        "ln_v_w": gain(ks[3], (DEPTH, D_A)),
        "ln_v_b": nrm(ks[4], (DEPTH, D_A), 0.02),
        "w_spatial": nrm(ks[5], (DEPTH, N_HEADS_A, GMLP_CHUNK, GMLP_CHUNK), GMLP_CHUNK ** -0.5),
        "b_spatial": gain(ks[6], (DEPTH, N_HEADS_A, GMLP_CHUNK)),
        "gmlp_out_norm": gain(ks[7], (DEPTH, D_A)),
        "hgrn_lb_fwd": nrm(ks[8], (DEPTH + 1, F_B), 0.1),
        "hgrn_lb_bwd": nrm(ks[9], (DEPTH + 1, F_B), 0.1),
        "hgrn_out_norm": gain(ks[10], (DEPTH, HEAD_B_V)),
        "w_out": nrm(ks[11], (DEPTH, D_MIX, D_MODEL), D_MIX ** -0.5),
        "moe_norm": gain(ks[12], (DEPTH, D_MODEL)),
        "w_router": nrm(ks[13], (DEPTH, D_MODEL, N_EXPERTS), D_MODEL ** -0.5),
        "b_router": nrm(ks[14], (DEPTH, N_EXPERTS), 0.01),
        "w1": nrm(ks[15], (DEPTH, N_EXPERTS, D_MODEL, 2 * D_EXPERT), D_MODEL ** -0.5),
        "b1": nrm(ks[16], (DEPTH, N_EXPERTS, 2 * D_EXPERT), 0.01),
        "w2": nrm(ks[17], (DEPTH, N_EXPERTS, D_EXPERT, D_MODEL), D_EXPERT ** -0.5),
        "b2": nrm(ks[18], (DEPTH, N_EXPERTS, D_MODEL), 0.01),
        "final_norm": gain(ks[19], (D_MODEL,)),
    }


def reference(x, mix_norm, w_in, ln_v_w, ln_v_b, w_spatial, b_spatial, gmlp_out_norm,
              hgrn_lb_fwd, hgrn_lb_bwd, hgrn_out_norm, w_out, moe_norm, w_router, b_router,
              w1, b1, w2, b2, final_norm):
    B, S, D = x.shape
    split_at = [D_A, 2 * D_A, 2 * D_A + F_B, 2 * D_A + 2 * F_B, 2 * D_A + 3 * F_B,
                2 * D_A + 3 * F_B + D_B]
    for l in range(DEPTH):
        h = rmsnorm(x, mix_norm[l])
        z = h @ w_in[l]
        u, v, q_raw, ff_raw, fb_raw, i_raw, g_raw = jnp.split(z, split_at, axis=-1)
        a = gmlp_mixer(jax.nn.gelu(u, approximate=False), jax.nn.gelu(v, approximate=False),
                       ln_v_w[l], ln_v_b[l], w_spatial[l], b_spatial[l])
        a = rmsnorm(a, gmlp_out_norm[l])
        bo = hgrn2_mixer(q_raw, ff_raw, fb_raw, i_raw, g_raw,
                         lower_bound(hgrn_lb_fwd, l), lower_bound(hgrn_lb_bwd, l), hgrn_out_norm[l])
        x = x + jnp.concatenate([a, bo], axis=-1) @ w_out[l]
        h2 = rmsnorm(x, moe_norm[l]).reshape(B * S, D)
        x = x + moe(h2, w_router[l], b_router[l], w1[l], b1[l], w2[l], b2[l]).reshape(B, S, D)
    return rmsnorm(x, final_norm)
```

```cpp
#include <hip/hip_runtime.h>
#include <cstdio>
#include <cstdint>

#ifndef MK_N_LAUNCHES
#define MK_N_LAUNCHES 0
#endif

namespace pg8 {
#define PG8_LAS __attribute__((address_space(3)))
typedef unsigned short bf16_t;
typedef short bf16x8 __attribute__((ext_vector_type(8)));
typedef float f32x4 __attribute__((ext_vector_type(4)));
typedef float f32x2 __attribute__((ext_vector_type(2)));
typedef unsigned u32x4 __attribute__((ext_vector_type(4)));
typedef unsigned u32x2 __attribute__((ext_vector_type(2)));
constexpr int BM = 256, BK = 64, HALF = 128, HTB = HALF * BK * 2, STAGE_BYTES = 8 * HTB, NXCD = 8, WGM = 8;

__host__ __device__ __forceinline__ int lds_byte(int r, int c) { const int st = (r >> 4) * 2 + (c >> 5), rr = r & 15, cc = c & 31, ob = rr * 64 + cc * 2; return st * 1024 + (ob ^ (((ob >> 9) & 1) << 5)); }
__host__ __device__ __forceinline__ void stage_rc(int b, int& R, int& C) { const int st = b / 1024, sb = b % 1024, swz = sb ^ (((sb >> 9) & 1) << 5); R = (st >> 1) * 16 + swz / 64; C = (st & 1) * 32 + (swz % 64) / 2; }
__host__ __device__ __forceinline__ int perm32(int rho) { const int n = rho >> 4, i = rho & 15; return 8 * (i >> 2) + 4 * n + (i & 3); }

struct Unit { int pm, pn, e; };

struct StaticOrder {
    const char* A; const char* Bt; size_t tstep;
    int nM, nN, nwg, G, c;
    __device__ void init(const void* A_, const void* Bt_, int M, int N, int K, int G_, int c_) { A = (const char*)A_; Bt = (const char*)Bt_; tstep = (size_t)BM * K * 2; nM = M / BM; nN = N / BM; nwg = nM * nN; G = G_; c = c_; }
    __device__ bool next(int i, Unit& u) const {
        const long L = (long)i * G + c; if (L >= nwg) return false;
        int wgid = (int)L; { const int q = nwg / NXCD, r = nwg % NXCD, xcd = wgid % NXCD, off = wgid / NXCD; wgid = (xcd < r ? xcd * (q + 1) : r * (q + 1) + (xcd - r) * q) + off; }
        const int nig = WGM * nN, gid = wgid / nig, fm = gid * WGM, gsz = (nM - fm) < WGM ? (nM - fm) : WGM;
        u.pm = fm + ((wgid % nig) % gsz); u.pn = (wgid % nig) / gsz; u.e = 0; return true;
    }
    __device__ __forceinline__ const char* abase(const Unit& u) const { return A + (size_t)u.pm * tstep; }
    __device__ __forceinline__ const char* bbase(const Unit& u) const { return Bt + (size_t)u.pn * tstep; }
};
struct GroupedOrder {
    const char* A; const char* Bt; size_t tstep, estep;
    const PG8_LAS unsigned char* tileE; int NT, nN, nU, G, c;
    __device__ void init(const void* A_, const void* Bt_, int K, int nN_, int NT_, const PG8_LAS unsigned char* tileE_, int G_, int c_) {
        A = (const char*)A_; Bt = (const char*)Bt_; tstep = (size_t)BM * K * 2; estep = (size_t)nN_ * tstep; tileE = tileE_; NT = NT_; nN = nN_; nU = NT_ * nN_; G = G_; c = c_; }
    __device__ bool next(int i, Unit& u) const {
        const int L = i * G + ((G % 8 == 0) ? ((c % 8) * (G / 8) + c / 8) : c); if (L >= nU) return false;
        const int png = L / (NT * 4), rem = L % (NT * 4); u.pm = rem >> 2; u.pn = png * 4 + (rem & 3); u.e = tileE[u.pm]; return true;
    }
    __device__ __forceinline__ const char* abase(const Unit& u) const { return A + (size_t)u.pm * tstep; }
    __device__ __forceinline__ const char* bbase(const Unit& u) const { return Bt + (size_t)u.e * estep + (size_t)u.pn * tstep; }
};

__device__ __forceinline__ unsigned cvt_pk_bf16(float lo, float hi) { unsigned r; asm volatile("v_cvt_pk_bf16_f32 %0, %1, %2" : "=v"(r) : "v"(lo), "v"(hi)); return r; }
__device__ __forceinline__ f32x2 gelu_pk(f32x2 v) {
    const f32x2 av = __builtin_elementwise_abs(v), d = av * 0.2316418882f + 1.0f;
    f32x2 t; t.x = __builtin_amdgcn_rcpf(d.x); t.y = __builtin_amdgcn_rcpf(d.y);
    f32x2 q = t * 0.5307027145f + (-0.7265760135f); q = q * t + 0.7107068705f; q = q * t + (-0.142248368f); q = q * t + 0.127414796f; q = q * t;
    const f32x2 s = (v * v) * (-0.72134752044f);
    f32x2 e; e.x = __builtin_amdgcn_exp2f(s.x); e.y = __builtin_amdgcn_exp2f(s.y);
    const f32x2 m = v * (q * e), r = v - m;
    f32x2 o; o.x = v.x < 0.f ? m.x : r.x; o.y = v.y < 0.f ? m.y : r.y; return o;
}
__device__ __forceinline__ float sigmoidf_fast(float x) { return __builtin_amdgcn_rcpf(1.0f + __builtin_amdgcn_exp2f(-1.44269504089f * x)); }
__device__ __forceinline__ float siluf_fast(float x) { return x * sigmoidf_fast(x); }


struct EpiZ {
    static constexpr bool PERM = true;
    bf16_t* O; int ldc;
    __device__ __forceinline__ void operator()(const f32x4 (&acc)[2][2][4][2], const Unit& u, int wr, int wc, int fr, int fq) const {
        const int row0 = u.pm * BM + wr * 64 + fr, col0 = u.pn * BM + wc * 32 + 8 * fq;
        const int act = (u.pn < 8) ? 1 : ((u.pn < 12 || u.pn >= 24) ? 2 : 0);
#pragma unroll
        for (int ai = 0; ai < 2; ++ai)
#pragma unroll
            for (int m = 0; m < 4; ++m) { bf16_t* rowp = O + (size_t)(row0 + ai * HALF + m * 16) * ldc + col0;
#pragma unroll
                for (int bj = 0; bj < 2; ++bj) { f32x4 v0 = acc[ai][bj][m][0], v1 = acc[ai][bj][m][1];
                    if (act == 1) { f32x2 a = gelu_pk((f32x2){v0[0], v0[1]}), b = gelu_pk((f32x2){v0[2], v0[3]}), c = gelu_pk((f32x2){v1[0], v1[1]}), d = gelu_pk((f32x2){v1[2], v1[3]});
                        v0 = (f32x4){a.x, a.y, b.x, b.y}; v1 = (f32x4){c.x, c.y, d.x, d.y}; }
                    else if (act == 2) {
#pragma unroll
                        for (int j = 0; j < 4; ++j) { v0[j] = siluf_fast(v0[j]); v1[j] = siluf_fast(v1[j]); } }
                    u32x4 w; w.x = cvt_pk_bf16(v0[0], v0[1]); w.y = cvt_pk_bf16(v0[2], v0[3]); w.z = cvt_pk_bf16(v1[0], v1[1]); w.w = cvt_pk_bf16(v1[2], v1[3]);
                    *(u32x4*)(rowp + bj * HALF) = w; } }
    }
};
struct EpiResF32 {
    static constexpr bool PERM = false;
    const float* R; float* C; int ldc;
    __device__ __forceinline__ void operator()(const f32x4 (&acc)[2][2][4][2], const Unit& u, int wr, int wc, int fr, int fq) const {
        const int row0 = u.pm * BM + wr * 64 + fr, col0 = u.pn * BM + wc * 32 + 4 * fq;
#pragma unroll
        for (int ai = 0; ai < 2; ++ai)
#pragma unroll
            for (int m = 0; m < 4; ++m) { const size_t off = (size_t)(row0 + ai * HALF + m * 16) * ldc + col0;
#pragma unroll
                for (int bj = 0; bj < 2; ++bj)
#pragma unroll
                    for (int n = 0; n < 2; ++n) { const f32x4 r = *(const f32x4*)(R + off + bj * HALF + n * 16); *(f32x4*)(C + off + bj * HALF + n * 16) = r + acc[ai][bj][m][n]; }
                asm volatile("" ::: "memory"); }
    }
};
struct EpiSwiglu {
    static constexpr bool PERM = true;
    bf16_t* O; const float* b1;
    __device__ __forceinline__ void operator()(const f32x4 (&acc)[2][2][4][2], const Unit& u, int wr, int wc, int fr, int fq) const {
        const int row0 = u.pm * BM + wr * 64 + fr, j0 = u.pn * HALF + wc * 32 + 8 * fq;
        const float* bp = b1 + (size_t)u.e * 4096 + 2 * j0;
        const f32x4 q0 = *(const f32x4*)(bp), q1 = *(const f32x4*)(bp + 4), q2 = *(const f32x4*)(bp + 8), q3 = *(const f32x4*)(bp + 12);
        const f32x4 bg0 = (f32x4){q0[0], q0[2], q1[0], q1[2]}, bl0 = (f32x4){q0[1], q0[3], q1[1], q1[3]};
        const f32x4 bg1 = (f32x4){q2[0], q2[2], q3[0], q3[2]}, bl1 = (f32x4){q2[1], q2[3], q3[1], q3[3]};
#pragma unroll
        for (int ai = 0; ai < 2; ++ai)
#pragma unroll
            for (int m = 0; m < 4; ++m) { bf16_t* rowp = O + (size_t)(row0 + ai * HALF + m * 16) * 2048 + j0;
                f32x4 o[2];
#pragma unroll
                for (int n = 0; n < 2; ++n) { const f32x4 g = acc[ai][0][m][n] + (n ? bg1 : bg0), l = acc[ai][1][m][n] + (n ? bl1 : bl0);
#pragma unroll
                    for (int j = 0; j < 4; ++j) { const float gg = fminf(g[j], 7.0f), ll = fminf(fmaxf(l[j], -7.0f), 7.0f);
                        o[n][j] = gg * sigmoidf_fast(1.702f * gg) * (ll + 1.0f); } }
                u32x4 w; w.x = cvt_pk_bf16(o[0][0], o[0][1]); w.y = cvt_pk_bf16(o[0][2], o[0][3]); w.z = cvt_pk_bf16(o[1][0], o[1][1]); w.w = cvt_pk_bf16(o[1][2], o[1][3]);
                *(u32x4*)rowp = w; }
    }
};
struct EpiY {
    static constexpr bool PERM = true;
    bf16_t* O; const float* b2; const float* gate;
    __device__ __forceinline__ void operator()(const f32x4 (&acc)[2][2][4][2], const Unit& u, int wr, int wc, int fr, int fq) const {
        const int row0 = u.pm * BM + wr * 64 + fr, col0 = u.pn * BM + wc * 32 + 8 * fq;
        const float* bp = b2 + (size_t)u.e * 2048 + col0;
        f32x4 bv[2][2];
#pragma unroll
        for (int bj = 0; bj < 2; ++bj)
#pragma unroll
            for (int n = 0; n < 2; ++n) bv[bj][n] = *(const f32x4*)(bp + bj * HALF + 4 * n);
#pragma unroll
        for (int ai = 0; ai < 2; ++ai)
#pragma unroll
            for (int m = 0; m < 4; ++m) { const int r = row0 + ai * HALF + m * 16; const float gt = gate[r]; bf16_t* rowp = O + (size_t)r * 2048 + col0;
#pragma unroll
                for (int bj = 0; bj < 2; ++bj) { const f32x4 v0 = (acc[ai][bj][m][0] + bv[bj][0]) * gt, v1 = (acc[ai][bj][m][1] + bv[bj][1]) * gt;
                    u32x4 w; w.x = cvt_pk_bf16(v0[0], v0[1]); w.y = cvt_pk_bf16(v0[2], v0[3]); w.z = cvt_pk_bf16(v1[0], v1[1]); w.w = cvt_pk_bf16(v1[2], v1[3]);
                    *(u32x4*)(rowp + bj * HALF) = w; } }
    }
};

template <class Epi, class Sched, bool ALIGN_EPI = true>
__device__ __forceinline__ void gemm_phase(PG8_LAS unsigned char* lds, const int K, const Sched& S, const Epi& E) {
    const int tid = threadIdx.x, wid = __builtin_amdgcn_readfirstlane(tid >> 6), lane = tid & 63, wr = wid >> 2, wc = wid & 3, fr = lane & 15, fq = lane >> 4;
    const int nt = K / BK;
    unsigned voffA[2], voffB[2];
#pragma unroll
    for (int i = 0; i < 2; ++i) { int R, C; stage_rc(tid * 16 + i * 8192, R, C); const int Rb = Epi::PERM ? ((R & ~31) + perm32(R & 31)) : R;
        voffA[i] = (unsigned)(R * K + C) * 2u; voffB[i] = (unsigned)(Rb * K + C) * 2u; }
    const size_t kstep = (size_t)(BK * 2);
    const size_t hstep = (size_t)HALF * K * 2;
    const unsigned ldsw = (unsigned)wid * 1024u;
    const int aoff = lds_byte(wr * 64 + fr, fq * 8), boff = lds_byte(wc * 32 + fr, fq * 8);
#define PG8_SA(b, h) (((b) * 2 + (h)) * HTB)
#define PG8_SB(b, h) ((4 + (b) * 2 + (h)) * HTB)
#define PG8_STAGE(bufoff, gbase, voff) do { _Pragma("unroll") for (int _i = 0; _i < 2; ++_i) \
        __builtin_amdgcn_global_load_lds((const unsigned*)((const char*)(gbase) + (voff)[_i]), (PG8_LAS unsigned*)(lds + (bufoff) + ldsw + _i * 8192), 16, 0, 0); } while (0)
#define PG8_LDA(dst, b, h) do { _Pragma("unroll") for (int m = 0; m < 4; ++m) _Pragma("unroll") for (int k = 0; k < 2; ++k) dst[m][k] = *(const PG8_LAS bf16x8*)(lds + PG8_SA(b, h) + aoff + m * 2048 + k * 1024); } while (0)
#define PG8_LDB(dst, b, h) do { _Pragma("unroll") for (int n = 0; n < 2; ++n) _Pragma("unroll") for (int k = 0; k < 2; ++k) dst[n][k] = *(const PG8_LAS bf16x8*)(lds + PG8_SB(b, h) + boff + n * 2048 + k * 1024); } while (0)
#define PG8_MMA(ai, bj, At, Bt) do { __builtin_amdgcn_s_setprio(1); _Pragma("unroll") for (int m = 0; m < 4; ++m) _Pragma("unroll") for (int n = 0; n < 2; ++n) _Pragma("unroll") for (int k = 0; k < 2; ++k) \
        acc[ai][bj][m][n] = __builtin_amdgcn_mfma_f32_16x16x32_bf16(Bt[n][k], At[m][k], acc[ai][bj][m][n], 0, 0, 0); __builtin_amdgcn_s_setprio(0); } while (0)
#define PG8_WAIT_V(n) asm volatile("s_waitcnt vmcnt(" #n ")" ::: "memory")
#define PG8_WAIT_L(n) asm volatile("s_waitcnt lgkmcnt(" #n ")" ::: "memory")
#define PG8_BAR __builtin_amdgcn_s_barrier()
#define PG8_SCHED __builtin_amdgcn_sched_barrier(0)
    Unit cur, nxt; int ui = 0;
    if (!S.next(0, cur)) return;
    f32x4 acc[2][2][4][2];
#pragma unroll
    for (int a = 0; a < 2; ++a)
#pragma unroll
        for (int b = 0; b < 2; ++b)
#pragma unroll
            for (int m = 0; m < 4; ++m)
#pragma unroll
                for (int n = 0; n < 2; ++n) acc[a][b][m][n] = (f32x4){0.f, 0.f, 0.f, 0.f};
    bf16x8 At[4][2], B0[2][2], B1[2][2];
    const char* cA = S.abase(cur); const char* cB = S.bbase(cur);
    PG8_STAGE(PG8_SB(0, 0), cB, voffB); PG8_STAGE(PG8_SB(0, 1), cB + hstep, voffB); PG8_STAGE(PG8_SA(0, 0), cA, voffA); PG8_STAGE(PG8_SA(0, 1), cA + hstep, voffA);
    if (wr == 1) PG8_BAR;
    PG8_WAIT_V(2); PG8_BAR;
    PG8_STAGE(PG8_SB(1, 0), cB + kstep, voffB); PG8_STAGE(PG8_SA(1, 0), cA + kstep, voffA); PG8_STAGE(PG8_SB(1, 1), cB + hstep + kstep, voffB);
    PG8_WAIT_V(6); PG8_BAR;
    for (;;) {
        const bool has_next = S.next(ui + 1, nxt);
        const char* nA = has_next ? S.abase(nxt) : cA; const char* nB = has_next ? S.bbase(nxt) : cB;
        for (int t = 0; t < nt; t += 2) {
            const bool last = (t == nt - 2);
            const char* a1 = cA + (size_t)(t + 1) * kstep;
            const char* a2 = last ? nA : cA + (size_t)(t + 2) * kstep; const char* b2 = last ? nB : cB + (size_t)(t + 2) * kstep;
            const char* a3 = a2 + kstep; const char* b3 = b2 + kstep;
            PG8_LDB(B0, 0, 0); PG8_LDB(B1, 0, 1); PG8_SCHED; PG8_LDA(At, 0, 0); PG8_STAGE(PG8_SA(1, 1), a1 + hstep, voffA);
            PG8_WAIT_V(8); PG8_WAIT_L(0); PG8_BAR; PG8_MMA(0, 0, At, B0); PG8_MMA(0, 1, At, B1); PG8_BAR; PG8_SCHED;
            PG8_LDA(At, 0, 1); PG8_STAGE(PG8_SB(0, 0), b2, voffB); PG8_STAGE(PG8_SB(0, 1), b2 + hstep, voffB); PG8_STAGE(PG8_SA(0, 0), a2, voffA);
            PG8_WAIT_V(8); PG8_WAIT_L(0); PG8_BAR; PG8_MMA(1, 0, At, B0); PG8_MMA(1, 1, At, B1); PG8_BAR; PG8_SCHED;
            PG8_LDB(B0, 1, 0); PG8_LDB(B1, 1, 1); PG8_SCHED; PG8_LDA(At, 1, 0); PG8_STAGE(PG8_SA(0, 1), a2 + hstep, voffA);
            PG8_WAIT_V(8); PG8_WAIT_L(0); PG8_BAR; PG8_MMA(0, 0, At, B0); PG8_MMA(0, 1, At, B1); PG8_BAR; PG8_SCHED;
            PG8_LDA(At, 1, 1); PG8_STAGE(PG8_SB(1, 0), b3, voffB); PG8_STAGE(PG8_SB(1, 1), b3 + hstep, voffB); PG8_STAGE(PG8_SA(1, 0), a3, voffA);
            PG8_WAIT_V(8); PG8_WAIT_L(0); PG8_BAR; PG8_MMA(1, 0, At, B0); PG8_MMA(1, 1, At, B1); PG8_BAR; PG8_SCHED;
        }
        if constexpr (ALIGN_EPI) { if (wr == 0) PG8_BAR; }
        E(acc, cur, wr, wc, fr, fq);
        if (!has_next) break;
#pragma unroll
        for (int a = 0; a < 2; ++a)
#pragma unroll
            for (int b = 0; b < 2; ++b)
#pragma unroll
                for (int m = 0; m < 4; ++m)
#pragma unroll
                    for (int n = 0; n < 2; ++n) acc[a][b][m][n] = (f32x4){0.f, 0.f, 0.f, 0.f};
        cur = nxt; cA = nA; cB = nB; ++ui;
        if constexpr (ALIGN_EPI) { if (wr == 1) PG8_BAR; }
    }
    PG8_WAIT_V(0);
    if constexpr (!ALIGN_EPI) { if (wr == 0) PG8_BAR; }
    PG8_BAR;
#undef PG8_SA
#undef PG8_SB
#undef PG8_STAGE
#undef PG8_LDA
#undef PG8_LDB
#undef PG8_MMA
#undef PG8_WAIT_V
#undef PG8_WAIT_L
#undef PG8_BAR
#undef PG8_SCHED
}
}

constexpr int NB = 8, SEQ = 2048, DM = 2048, NTOK = NB * SEQ, INC = 7168, DA = 1024, NEXP = 32, TOPK = 4, DEXP = 2048;
constexpr int CAP = 16384;
constexpr int MAXT = NTOK * TOPK / 256 + NEXP;
constexpr int PROWS = MAXT * 256;
constexpr float EPS = 1e-5f;
constexpr int ZU = 0, ZV = 1024, ZQ = 2048, ZFF = 3072, ZFB = 4096, ZI = 5120, ZG = 6144;
constexpr int NWAVES = 8, NTHREADS = 512;

constexpr size_t MiB = 1u << 20;
constexpr size_t WS_CTL = 0, CTL_ZERO_BYTES = 64 * 1024;
constexpr size_t WS_WIN_T = 1 * MiB;
constexpr size_t WS_WOUT_T = 29 * MiB;
constexpr size_t WS_WRT = 37 * MiB;
constexpr size_t WS_H = 38 * MiB;
constexpr size_t WS_Z = 102 * MiB;
constexpr size_t WS_ARAW = 326 * MiB;
constexpr size_t WS_OF = 358 * MiB;
constexpr size_t WS_OB = 422 * MiB;
constexpr size_t WS_CAT = 486 * MiB;
constexpr size_t WS_X1 = 550 * MiB;
constexpr size_t WS_ROUTE = 678 * MiB;
constexpr size_t RT_TOKE = 0, RT_TOKPOS = 256 * 1024, RT_ROWG = 512 * 1024, RT_LIST = 1 * MiB, RT_LISTG = 3 * MiB, RT_END = 5 * MiB;
static_assert(RT_ROWG + (size_t)PROWS * 4 <= RT_LIST && RT_LIST + (size_t)NEXP * CAP * 4 <= RT_LISTG && RT_LISTG + (size_t)NEXP * CAP * 4 <= RT_END && RT_END <= 8 * MiB, "route map");
constexpr size_t WS_XG = 686 * MiB;
constexpr size_t WS_ACT = 974 * MiB;
constexpr size_t WS_Y = 1262 * MiB;
constexpr size_t WS_W1T = 1550 * MiB;
constexpr size_t WS_W2T = 2062 * MiB;
constexpr size_t WS_END = 2318 * MiB;
static_assert(WS_WIN_T + (size_t)INC * DM * 2 <= WS_WOUT_T && WS_WOUT_T + (size_t)DM * DM * 2 <= WS_WRT && WS_WRT + (size_t)NEXP * DM * 4 <= WS_H && WS_H + (size_t)NTOK * DM * 2 <= WS_Z &&
              WS_Z + (size_t)NTOK * INC * 2 <= WS_ARAW && WS_ARAW + (size_t)NTOK * DA * 2 <= WS_OF && WS_OF + (size_t)NTOK * DA * 4 <= WS_OB && WS_OB + (size_t)NTOK * DA * 4 <= WS_CAT &&
              WS_CAT + (size_t)NTOK * DM * 2 <= WS_X1 && WS_X1 + (size_t)NTOK * DM * 4 <= WS_ROUTE && WS_ROUTE + 8 * MiB <= WS_XG && WS_XG + (size_t)PROWS * DM * 2 <= WS_ACT &&
              WS_ACT + (size_t)PROWS * DEXP * 2 <= WS_Y && WS_Y + (size_t)PROWS * DM * 2 <= WS_W1T && WS_W1T + (size_t)NEXP * 4096 * DM * 2 <= WS_W2T && WS_W2T + (size_t)NEXP * DM * DEXP * 2 <= WS_END, "ws map");
constexpr int CW_BAR = 4096;
constexpr int CW_CNT = 8192;

constexpr int RING_OFF = 0, RING_BYTES = 131072;
constexpr int SMALL_OFF = RING_BYTES, SMALL_BYTES = 12288;
constexpr int MISC_OFF = SMALL_OFF + SMALL_BYTES;
constexpr int LDS_BYTES = 147456;
static_assert(MISC_OFF + 64 <= LDS_BYTES, "LDS map");

#define GAS __attribute__((address_space(1)))
#define LAS __attribute__((address_space(3)))
typedef unsigned short bf16;
typedef unsigned v4u __attribute__((ext_vector_type(4)));
typedef unsigned v2u __attribute__((ext_vector_type(2)));
typedef float f32x4 __attribute__((ext_vector_type(4)));
#define LDS_WAIT() asm volatile("s_waitcnt lgkmcnt(0)" ::: "memory")
#define VM_WAIT() asm volatile("s_waitcnt vmcnt(0)" ::: "memory")
__device__ __forceinline__ unsigned f2bf(float f) { unsigned u = __builtin_bit_cast(unsigned, f); return (u + 0x7fffu + ((u >> 16) & 1u)) >> 16; }
__device__ __forceinline__ unsigned pk2(float lo, float hi) { return f2bf(lo) | (f2bf(hi) << 16); }
__device__ __forceinline__ float bf2f(unsigned short b) { return __builtin_bit_cast(float, (unsigned)b << 16); }
__device__ __forceinline__ float bflo(unsigned w) { return __builtin_bit_cast(float, w << 16); }
__device__ __forceinline__ float bfhi(unsigned w) { return __builtin_bit_cast(float, w & 0xffff0000u); }
__device__ __forceinline__ float wave_sum(float v) {
#pragma unroll
    for (int o = 1; o < 64; o <<= 1) v += __shfl_xor(v, o);
    return v;
}

#define XB_TMO      128
#define XB_XCNT(j)  (256  + 64 * (j))
#define XB_XSUB(j)  (1280 + 64 * (j))
#define XB_XGEN(j)  (2304 + 64 * (j))
#define XB_TOP      3328
#define XB_TOPGEN   3392
#define XCD_BAR_WORDS 3456
#define XB_SPIN_CAP (1u << 18)
__device__ __forceinline__ unsigned xb_ld(unsigned* p)              { return __hip_atomic_load(p, __ATOMIC_RELAXED, __HIP_MEMORY_SCOPE_AGENT); }
__device__ __forceinline__ unsigned xb_add(unsigned* p, unsigned v) { return __hip_atomic_fetch_add(p, v, __ATOMIC_RELAXED, __HIP_MEMORY_SCOPE_AGENT); }
__device__ __forceinline__ unsigned xb_xcc_id() { return (unsigned)__builtin_amdgcn_s_getreg((3 << 11) | 20) & 0xFu; }
#define XB_SPIN(cond, bar) do { unsigned _sp = 0; while (cond) { __builtin_amdgcn_s_sleep(1); \
    if ((++_sp & 255u) == 0u) { if (xb_ld(&(bar)[XB_TMO])) break; if (_sp > XB_SPIN_CAP) { atomicAdd(&(bar)[XB_TMO], 1u); break; } } } } while (0)
struct XcdBarrier { unsigned* bar; unsigned x; volatile LAS unsigned* st; };
__device__ __forceinline__ XcdBarrier xcd_barrier_post(unsigned* bar, volatile LAS unsigned* st) {
    XcdBarrier b; b.bar = bar; b.x = xb_xcc_id(); b.st = st;
    if (threadIdx.x == 0) (void)xb_add(&bar[XB_XCNT(b.x)], 1u);
    return b;
}
__device__ __forceinline__ void xcd_barrier_complete(unsigned* bar, unsigned x, unsigned& nloc, unsigned& nx) {
    const unsigned G = gridDim.x * gridDim.y * gridDim.z;
    unsigned sum, cnt, mine, sp = 0u;
    for (;;) {
        sum = 0u; cnt = 0u; mine = 0u;
#pragma unroll
        for (unsigned j = 0; j < 16; ++j) { const unsigned c = xb_ld(&bar[XB_XCNT(j)]); sum += c; cnt += (c > 0u) ? 1u : 0u; mine = (j == x) ? c : mine; }
        if (sum == G) break;
        __builtin_amdgcn_s_sleep(1);
        if ((++sp & 255u) == 0u) { if (xb_ld(&bar[XB_TMO])) break; if (sp > XB_SPIN_CAP) { atomicAdd(&bar[XB_TMO], 1u); break; } }
    }
    nloc = mine > 0u ? mine : 1u; nx = cnt > 0u ? cnt : 1u;
}
__device__ __forceinline__ void xcd_barrier(const XcdBarrier& b) {
    asm volatile("s_waitcnt vmcnt(0)" ::: "memory");
    __syncthreads();
    if (threadIdx.x == 0) {
        unsigned* bar = b.bar;
        __builtin_amdgcn_s_waitcnt(0);
        unsigned nloc = b.st[0], nx = b.st[1];
        if (nloc == 0u) { xcd_barrier_complete(bar, b.x, nloc, nx); b.st[0] = nloc; b.st[1] = nx; }
        const unsigned old = xb_add(&bar[XB_XSUB(b.x)], 1u);
        const unsigned gen = old / nloc;
        if (old + 1u == (gen + 1u) * nloc) {
            __builtin_amdgcn_fence(__ATOMIC_RELEASE, "agent");
            asm volatile("s_waitcnt vmcnt(0)" ::: "memory");
            const unsigned og = xb_add(&bar[XB_TOP], 1u);
            const unsigned tg = og / nx;
            if (og + 1u == (tg + 1u) * nx) xb_add(&bar[XB_TOPGEN], 1u);
            else XB_SPIN(xb_ld(&bar[XB_TOPGEN]) == tg, bar);
            __builtin_amdgcn_fence(__ATOMIC_ACQUIRE, "agent");
            xb_add(&bar[XB_XGEN(b.x)], 1u);
            asm volatile("s_waitcnt vmcnt(0)" ::: "memory");
        } else {
            XB_SPIN(xb_ld(&bar[XB_XGEN(b.x)]) == gen, bar);
            __builtin_amdgcn_fence(__ATOMIC_ACQUIRE, "agent");
            asm volatile("s_waitcnt vmcnt(0)" ::: "memory");
        }
    }
    __syncthreads();
}

struct Args { const float* in[20]; float* out; unsigned char* ws; int ph_lo, ph_hi; };
enum { I_X = 0, I_MIXN, I_WIN, I_LNW, I_LNB, I_WSP, I_BSP, I_GON, I_LBF, I_LBB, I_HON, I_WOUT, I_MOEN, I_WR, I_BR, I_W1, I_B1, I_W2, I_B2, I_FIN };

struct Frame {
    LAS unsigned char* lds;
    int tid, lane, wave, G, gw, NGW;
};

template <bool PERMW1>
__device__ __forceinline__ void p0_transpose_item(const float* W, int K, int N, bf16* WT, LAS float* scr, int item, int lane) {
    const int nblk = N / 32, kb = item / nblk, nb = item % nblk, k0 = 64 * kb, n0 = 32 * nb;
#pragma unroll 8
    for (int i = 0; i < 32; ++i) { const int kk = 2 * i + (lane >> 5); scr[kk * 33 + (lane & 31)] = W[(size_t)(k0 + kk) * N + n0 + (lane & 31)]; }
    LDS_WAIT(); asm volatile("" ::: "memory");
    const int c = lane & 7;
#pragma unroll
    for (int j = 0; j < 4; ++j) { const int n = (lane >> 3) + 8 * j; const LAS float* s = scr + (8 * c) * 33 + n;
        v4u o; o.x = pk2(s[0 * 33], s[1 * 33]); o.y = pk2(s[2 * 33], s[3 * 33]); o.z = pk2(s[4 * 33], s[5 * 33]); o.w = pk2(s[6 * 33], s[7 * 33]);
        const int ng = n0 + n; const int drow = PERMW1 ? ((ng >> 8) * 256 + (ng & 1) * 128 + ((ng & 255) >> 1)) : ng;
        *(GAS v4u*)(WT + (size_t)drow * K + k0 + 8 * c) = o; }
    LDS_WAIT(); asm volatile("" ::: "memory");
}
__device__ __forceinline__ void rms_row_to_bf16(const float* xrow, const float* w, bf16* orow, int lane) {
    const GAS f32x4* xr = (const GAS f32x4*)xrow + lane; const GAS f32x4* wr = (const GAS f32x4*)w + lane;
    f32x4 v[8]; float s = 0.f;
#pragma unroll
    for (int j = 0; j < 8; ++j) { v[j] = xr[64 * j]; s += (v[j].x * v[j].x + v[j].y * v[j].y) + (v[j].z * v[j].z + v[j].w * v[j].w); }
    const float r = 1.0f / sqrtf(wave_sum(s) * (1.f / DM) + EPS);
    GAS v2u* o8 = (GAS v2u*)orow + lane;
#pragma unroll
    for (int j = 0; j < 8; ++j) { const f32x4 g = wr[64 * j]; v2u o; o.x = pk2(v[j].x * r * g.x, v[j].y * r * g.y); o.y = pk2(v[j].z * r * g.z, v[j].w * r * g.w); o8[64 * j] = o; }
}
__device__ __forceinline__ void p0_prologue(const Frame& F, const Args& a) {
    LAS float* scr = (LAS float*)(F.lds + RING_OFF + F.wave * 16384);
    const float* Win = a.in[I_WIN]; const float* Wout = a.in[I_WOUT]; const float* W1 = a.in[I_W1]; const float* W2 = a.in[I_W2];
    bf16* WinT = (bf16*)(a.ws + WS_WIN_T); bf16* WoutT = (bf16*)(a.ws + WS_WOUT_T); bf16* W1T = (bf16*)(a.ws + WS_W1T); bf16* W2T = (bf16*)(a.ws + WS_W2T);
    constexpr int I_IN = (DM / 64) * (INC / 32), I_OUT = (DM / 64) * (DM / 32), I_E1 = (DM / 64) * (4096 / 32), I_E2 = (DEXP / 64) * (DM / 32);
    constexpr int NITEMS = I_IN + I_OUT + NEXP * I_E1 + NEXP * I_E2;
    for (int it = F.gw; it < NITEMS; it += F.NGW) {
        int r = it;
        if (r < I_IN) { p0_transpose_item<false>(Win, DM, INC, WinT, scr, r, F.lane); continue; } r -= I_IN;
        if (r < I_OUT) { p0_transpose_item<false>(Wout, DM, DM, WoutT, scr, r, F.lane); continue; } r -= I_OUT;
        if (r < NEXP * I_E1) { const int e = r / I_E1; p0_transpose_item<true>(W1 + (size_t)e * DM * 4096, DM, 4096, W1T + (size_t)e * 4096 * DM, scr, r % I_E1, F.lane); continue; } r -= NEXP * I_E1;
        { const int e = r / I_E2; p0_transpose_item<false>(W2 + (size_t)e * DEXP * DM, DEXP, DM, W2T + (size_t)e * DM * DEXP, scr, r % I_E2, F.lane); }
    }
    { float* WRT = (float*)(a.ws + WS_WRT); const float* Wr = a.in[I_WR];
      for (int i = blockIdx.x * NTHREADS + F.tid; i < DM * NEXP; i += F.G * NTHREADS) { const int e = i / DM, d = i % DM; WRT[i] = Wr[(size_t)d * NEXP + e]; } }
    bf16* H = (bf16*)(a.ws + WS_H);
    for (int m = F.gw; m < NTOK; m += F.NGW) rms_row_to_bf16(a.in[I_X] + (size_t)m * DM, a.in[I_MIXN], H + (size_t)m * DM, F.lane);
}

__device__ __forceinline__ void gmlp_item(const Frame& F, const Args& a, int item) {
    const bf16* Z = (const bf16*)(a.ws + WS_Z); bf16* ARAW = (bf16*)(a.ws + WS_ARAW);
    LAS float* Vn = (LAS float*)(F.lds + RING_OFF);
    LAS float* Wl = (LAS float*)(F.lds + RING_OFF + 65536);
    LAS float* st = (LAS float*)(F.lds + SMALL_OFF);
    const int row0 = item * 128;
    for (int r = 0; r < 16; ++r) { const int row = 16 * F.wave + r;
        const GAS v4u* vp = (const GAS v4u*)(Z + (size_t)(row0 + row) * INC + ZV + 16 * F.lane);
        const v4u q0 = vp[0], q1 = vp[1]; float x[16];
        x[0] = bflo(q0.x); x[1] = bfhi(q0.x); x[2] = bflo(q0.y); x[3] = bfhi(q0.y); x[4] = bflo(q0.z); x[5] = bfhi(q0.z); x[6] = bflo(q0.w); x[7] = bfhi(q0.w);
        x[8] = bflo(q1.x); x[9] = bfhi(q1.x); x[10] = bflo(q1.y); x[11] = bfhi(q1.y); x[12] = bflo(q1.z); x[13] = bfhi(q1.z); x[14] = bflo(q1.w); x[15] = bfhi(q1.w);
        float s = 0.f;
#pragma unroll
        for (int i = 0; i < 16; ++i) s += x[i];
        const float mu = wave_sum(s) * (1.f / DA); float q = 0.f;
#pragma unroll
        for (int i = 0; i < 16; ++i) { const float d = x[i] - mu; q += d * d; }
        const float rstd = 1.0f / sqrtf(wave_sum(q) * (1.f / DA) + EPS);
        if (F.lane == 0) { st[row] = mu; st[128 + row] = rstd; } }
    __syncthreads();
    for (int h = 0; h < 8; ++h) {
        {
            const int s = F.tid >> 2, c0 = (F.tid & 3) * 32; const float mu = st[s], rstd = st[128 + s];
            const GAS v4u* vp = (const GAS v4u*)(Z + (size_t)(row0 + s) * INC + ZV + h * 128 + c0);
            const float* lw = a.in[I_LNW] + h * 128 + c0; const float* lb = a.in[I_LNB] + h * 128 + c0;
#pragma unroll
            for (int j = 0; j < 4; ++j) { const v4u q = vp[j]; const unsigned w[4] = {q.x, q.y, q.z, q.w};
#pragma unroll
                for (int i = 0; i < 4; ++i) { const int c = 8 * j + 2 * i;
                    Vn[s * 128 + c0 + c] = (bflo(w[i]) - mu) * rstd * lw[c] + lb[c];
                    Vn[s * 128 + c0 + c + 1] = (bfhi(w[i]) - mu) * rstd * lw[c + 1] + lb[c + 1]; } }
            const GAS f32x4* wp = (const GAS f32x4*)(a.in[I_WSP] + (size_t)h * 16384);
#pragma unroll
            for (int j = 0; j < 8; ++j) { const int idx = F.tid + 512 * j; *(LAS f32x4*)(Wl + 4 * idx) = wp[idx]; }
        }
        __syncthreads();
        const int d = F.tid & 127, t0 = 32 * (F.tid >> 7);
        float acc[32];
#pragma unroll
        for (int i = 0; i < 32; ++i) acc[i] = 0.f;
        for (int s4 = 0; s4 < 32; ++s4) {
            const float v0 = Vn[(4 * s4 + 0) * 128 + d], v1 = Vn[(4 * s4 + 1) * 128 + d], v2 = Vn[(4 * s4 + 2) * 128 + d], v3 = Vn[(4 * s4 + 3) * 128 + d];
#pragma unroll
            for (int tt = 0; tt < 32; ++tt) { const f32x4 w = *(const LAS f32x4*)(Wl + (t0 + tt) * 128 + 4 * s4); acc[tt] += (w.x * v0 + w.y * v1) + (w.z * v2 + w.w * v3); }
        }
        const float* bs = a.in[I_BSP] + h * 128;
#pragma unroll
        for (int tt = 0; tt < 32; ++tt) { const int t = t0 + tt; const float u = bf2f(Z[(size_t)(row0 + t) * INC + ZU + h * 128 + d]);
            ARAW[(size_t)(row0 + t) * DA + h * 128 + d] = (bf16)f2bf(u * (acc[tt] + bs[t])); }
        __syncthreads();
    }
}

__device__ __forceinline__ void hgrn_item(const Frame& F, const Args& a, int item) {
    const bf16* Z = (const bf16*)(a.ws + WS_Z);
    const int b = item >> 5, h = (item >> 2) & 7, dir = (item >> 1) & 1, vh = item & 1;
    float* O = (float*)(a.ws + (dir ? WS_OB : WS_OF));
    LAS float* G = (LAS float*)(F.lds + RING_OFF);
    LAS float* P = (LAS float*)(F.lds + RING_OFF + 16384);
    const float* tab = a.in[dir ? I_LBB : I_LBF];
    const int gs = F.tid >> 6, gk = F.tid & 63;
    float lb0, lb1;
    { const float t0 = tab[h * 128 + gk], t1 = tab[1024 + h * 128 + gk]; lb0 = 1.0f / (1.0f + expf(t1 - t0));
      const float u0 = tab[h * 128 + gk + 64], u1 = tab[1024 + h * 128 + gk + 64]; lb1 = 1.0f / (1.0f + expf(u1 - u0)); }
    float S[16];
#pragma unroll
    for (int i = 0; i < 16; ++i) S[i] = 0.f;
    const int zf = dir ? ZFB : ZFF;
    for (int sb = 0; sb < SEQ / 8; ++sb) {
        { const int tau = sb * 8 + gs, t = dir ? (SEQ - 1 - tau) : tau; const bf16* zr = Z + (size_t)(b * SEQ + t) * INC + h * 128;
          const float f0 = lb0 + (1.0f - lb0) * (1.0f / (1.0f + expf(-bf2f(zr[zf + gk])))), f1 = lb1 + (1.0f - lb1) * (1.0f / (1.0f + expf(-bf2f(zr[zf + gk + 64]))));
          G[(gs * 3 + 0) * 128 + gk] = f0; G[(gs * 3 + 0) * 128 + gk + 64] = f1;
          G[(gs * 3 + 1) * 128 + gk] = 1.0f - f0; G[(gs * 3 + 1) * 128 + gk + 64] = 1.0f - f1;
          G[(gs * 3 + 2) * 128 + gk] = bf2f(zr[ZQ + gk]); G[(gs * 3 + 2) * 128 + gk + 64] = bf2f(zr[ZQ + gk + 64]); }
        __syncthreads();
#pragma unroll
        for (int st = 0; st < 8; ++st) { const int tau = sb * 8 + st, t = dir ? (SEQ - 1 - tau) : tau;
            const float v = bf2f(Z[(size_t)(b * SEQ + t) * INC + ZI + h * 128 + vh * 64 + F.lane]);
            float o = 0.f;
#pragma unroll
            for (int i4 = 0; i4 < 4; ++i4) { const f32x4 f = *(const LAS f32x4*)(G + (st * 3 + 0) * 128 + 16 * F.wave + 4 * i4), kk = *(const LAS f32x4*)(G + (st * 3 + 1) * 128 + 16 * F.wave + 4 * i4), q = *(const LAS f32x4*)(G + (st * 3 + 2) * 128 + 16 * F.wave + 4 * i4);
#pragma unroll
                for (int j = 0; j < 4; ++j) { S[4 * i4 + j] = f[j] * S[4 * i4 + j] + kk[j] * v; o += q[j] * S[4 * i4 + j]; } }
            P[(st * 8 + F.wave) * 64 + F.lane] = o; }
        __syncthreads();
        { const int tau = sb * 8 + gs, t = dir ? (SEQ - 1 - tau) : tau; float o = 0.f;
#pragma unroll
          for (int w = 0; w < 8; ++w) o += P[(gs * 8 + w) * 64 + gk];
          O[(size_t)(b * SEQ + t) * DA + h * 128 + vh * 64 + gk] = o; }
    }
    __syncthreads();
}

__device__ __forceinline__ void unpack16(const v4u q0, const v4u q1, float (&x)[16]) {
    x[0] = bflo(q0.x); x[1] = bfhi(q0.x); x[2] = bflo(q0.y); x[3] = bfhi(q0.y); x[4] = bflo(q0.z); x[5] = bfhi(q0.z); x[6] = bflo(q0.w); x[7] = bfhi(q0.w);
    x[8] = bflo(q1.x); x[9] = bfhi(q1.x); x[10] = bflo(q1.y); x[11] = bfhi(q1.y); x[12] = bflo(q1.z); x[13] = bfhi(q1.z); x[14] = bflo(q1.w); x[15] = bfhi(q1.w);
}
__device__ __forceinline__ void p3_cat(const Frame& F, const Args& a) {
    const bf16* Z = (const bf16*)(a.ws + WS_Z); const bf16* ARAW = (const bf16*)(a.ws + WS_ARAW);
    const float* OF = (const float*)(a.ws + WS_OF); const float* OB = (const float*)(a.ws + WS_OB); bf16* CAT = (bf16*)(a.ws + WS_CAT);
    const float* gon = a.in[I_GON] + 16 * F.lane; const float* hon = a.in[I_HON] + (F.lane & 7) * 16;
    for (int m = F.gw; m < NTOK; m += F.NGW) {
        float x[16];
        { const GAS v4u* ap = (const GAS v4u*)(ARAW + (size_t)m * DA + 16 * F.lane); unpack16(ap[0], ap[1], x); }
        float s = 0.f;
#pragma unroll
        for (int i = 0; i < 16; ++i) s += x[i] * x[i];
        const float r = 1.0f / sqrtf(wave_sum(s) * (1.f / DA) + EPS);
        v4u o0, o1;
        o0.x = pk2(x[0] * r * gon[0], x[1] * r * gon[1]); o0.y = pk2(x[2] * r * gon[2], x[3] * r * gon[3]); o0.z = pk2(x[4] * r * gon[4], x[5] * r * gon[5]); o0.w = pk2(x[6] * r * gon[6], x[7] * r * gon[7]);
        o1.x = pk2(x[8] * r * gon[8], x[9] * r * gon[9]); o1.y = pk2(x[10] * r * gon[10], x[11] * r * gon[11]); o1.z = pk2(x[12] * r * gon[12], x[13] * r * gon[13]); o1.w = pk2(x[14] * r * gon[14], x[15] * r * gon[15]);
        GAS v4u* cp = (GAS v4u*)(CAT + (size_t)m * DM + 16 * F.lane); cp[0] = o0; cp[1] = o1;
        float g[16];
        { const GAS v4u* gp = (const GAS v4u*)(Z + (size_t)m * INC + ZG + 16 * F.lane); unpack16(gp[0], gp[1], g); }
        const GAS f32x4* fp = (const GAS f32x4*)(OF + (size_t)m * DA + 16 * F.lane); const GAS f32x4* bp = (const GAS f32x4*)(OB + (size_t)m * DA + 16 * F.lane);
        float ss = 0.f;
#pragma unroll
        for (int j = 0; j < 4; ++j) { const f32x4 u = fp[j] + bp[j]; x[4 * j] = u.x; x[4 * j + 1] = u.y; x[4 * j + 2] = u.z; x[4 * j + 3] = u.w; ss += (u.x * u.x + u.y * u.y) + (u.z * u.z + u.w * u.w); }
        ss += __shfl_xor(ss, 1); ss += __shfl_xor(ss, 2); ss += __shfl_xor(ss, 4);
        const float rh = 1.0f / sqrtf(ss * (1.f / 128.f) + EPS);
#pragma unroll
        for (int i = 0; i < 16; ++i) x[i] = x[i] * rh * hon[i] * g[i];
        o0.x = pk2(x[0], x[1]); o0.y = pk2(x[2], x[3]); o0.z = pk2(x[4], x[5]); o0.w = pk2(x[6], x[7]);
        o1.x = pk2(x[8], x[9]); o1.y = pk2(x[10], x[11]); o1.z = pk2(x[12], x[13]); o1.w = pk2(x[14], x[15]);
        cp = (GAS v4u*)(CAT + (size_t)m * DM + DA + 16 * F.lane); cp[0] = o0; cp[1] = o1;
    }
}

__device__ __forceinline__ void p5_route(const Frame& F, const Args& a) {
    const float* X1 = (const float*)(a.ws + WS_X1); bf16* H2 = (bf16*)(a.ws + WS_H); const float* WRT = (const float*)(a.ws + WS_WRT);
    unsigned* ctl = (unsigned*)(a.ws + WS_CTL);
    int* tok_e = (int*)(a.ws + WS_ROUTE + RT_TOKE); int* tok_pos = (int*)(a.ws + WS_ROUTE + RT_TOKPOS);
    int* list = (int*)(a.ws + WS_ROUTE + RT_LIST); float* listg = (float*)(a.ws + WS_ROUTE + RT_LISTG);
    LAS int* hist = (LAS int*)(F.lds + SMALL_OFF);
    LAS int* base = hist + 32;
    LAS int* asg_e = hist + 64;
    LAS int* asg_rank = hist + 64 + 256;
    LAS float* asg_gate = (LAS float*)(hist + 64 + 512);
    LAS float* lg = (LAS float*)(hist + 64 + 768);
    const float* mn = a.in[I_MOEN]; const float* br = a.in[I_BR];
    for (int chunk = blockIdx.x; chunk < NTOK / 64; chunk += F.G) {
        if (F.tid < 32) hist[F.tid] = 0;
        const int m0 = chunk * 64 + 8 * F.wave;
        for (int grp = 0; grp < 4; ++grp) {
            f32x4 hv[2][8];
#pragma unroll
            for (int tk = 0; tk < 2; ++tk) { const int m = m0 + 2 * grp + tk; const GAS f32x4* xr = (const GAS f32x4*)(X1 + (size_t)m * DM) + F.lane; float s = 0.f;
#pragma unroll
                for (int j = 0; j < 8; ++j) { hv[tk][j] = xr[64 * j]; const f32x4 v = hv[tk][j]; s += (v.x * v.x + v.y * v.y) + (v.z * v.z + v.w * v.w); }
                const float r = 1.0f / sqrtf(wave_sum(s) * (1.f / DM) + EPS);
                GAS v2u* o8 = (GAS v2u*)(H2 + (size_t)m * DM) + F.lane;
#pragma unroll
                for (int j = 0; j < 8; ++j) { const f32x4 g = ((const GAS f32x4*)mn)[F.lane + 64 * j]; f32x4 v = hv[tk][j]; v.x *= r * g.x; v.y *= r * g.y; v.z *= r * g.z; v.w *= r * g.w; hv[tk][j] = v;
                    v2u o; o.x = pk2(v.x, v.y); o.y = pk2(v.z, v.w); o8[64 * j] = o; } }
#pragma unroll 2
            for (int e = 0; e < 32; ++e) { const GAS f32x4* wp = (const GAS f32x4*)(WRT + (size_t)e * DM) + F.lane; float s0 = 0.f, s1 = 0.f;
#pragma unroll
                for (int j = 0; j < 8; ++j) { const f32x4 w = wp[64 * j]; const f32x4 p = hv[0][j], q = hv[1][j];
                    s0 += (w.x * p.x + w.y * p.y) + (w.z * p.z + w.w * p.w); s1 += (w.x * q.x + w.y * q.y) + (w.z * q.z + w.w * q.w); }
                s0 = wave_sum(s0); s1 = wave_sum(s1);
                if (F.lane == 0) { lg[(8 * F.wave + 2 * grp) * 33 + e] = s0; lg[(8 * F.wave + 2 * grp + 1) * 33 + e] = s1; } }
        }
        __syncthreads();
        if (F.tid < 64) {
            float l[32];
#pragma unroll
            for (int e = 0; e < 32; ++e) l[e] = lg[F.tid * 33 + e] + br[e];
            int sel[4]; float val[4];
#pragma unroll
            for (int j = 0; j < 4; ++j) { float best = -3.0e38f; int bi = 0;
#pragma unroll
                for (int e = 0; e < 32; ++e) { if (l[e] > best) { best = l[e]; bi = e; } }
                sel[j] = bi; val[j] = best;
#pragma unroll
                for (int e = 0; e < 32; ++e) l[e] = (e == bi) ? -3.0e38f : l[e]; }
            const float e1 = expf(val[1] - val[0]), e2 = expf(val[2] - val[0]), e3 = expf(val[3] - val[0]); const float inv = 1.0f / (1.0f + e1 + e2 + e3);
            const float gt[4] = {inv, e1 * inv, e2 * inv, e3 * inv};
#pragma unroll
            for (int j = 0; j < 4; ++j) { const int slot = F.tid * 4 + j; const int rk = atomicAdd((int*)&hist[sel[j]], 1); asg_e[slot] = sel[j]; asg_rank[slot] = rk; asg_gate[slot] = gt[j]; }
        }
        __syncthreads();
        if (F.tid < 32) base[F.tid] = (int)atomicAdd(&ctl[CW_CNT + 64 * F.tid], (unsigned)hist[F.tid]);
        __syncthreads();
        if (F.tid < 256) { const int tok = chunk * 64 + (F.tid >> 2), j = F.tid & 3; const int e = asg_e[F.tid], pos = base[e] + asg_rank[F.tid];
            list[(size_t)e * CAP + pos] = tok; listg[(size_t)e * CAP + pos] = asg_gate[F.tid]; tok_e[tok * 4 + j] = e; tok_pos[tok * 4 + j] = pos; }
        __syncthreads();
    }
}

__device__ __forceinline__ int build_tiles(const Frame& F, const Args& a) {
    unsigned* ctl = (unsigned*)(a.ws + WS_CTL);
    LAS int* cnt = (LAS int*)(F.lds + SMALL_OFF + 4096); LAS int* tstart = cnt + 32; LAS unsigned char* tileE = (LAS unsigned char*)(tstart + 64);
    __syncthreads();
    if (F.tid < 64) { const int e = F.tid & 31; const int c = (int)__hip_atomic_load(&ctl[CW_CNT + 64 * e], __ATOMIC_RELAXED, __HIP_MEMORY_SCOPE_AGENT); const int nt = (c + 255) >> 8;
        int incl = nt;
#pragma unroll
        for (int o = 1; o < 32; o <<= 1) { const int v = __shfl_up(incl, o); if ((F.tid & 31) >= o) incl += v; }
        if (F.tid < 32) { cnt[e] = c; tstart[e] = incl - nt; if (e == 31) tstart[32] = incl;
            for (int t = incl - nt; t < incl; ++t) tileE[t] = (unsigned char)e; } }
    __syncthreads();
    return tstart[32];
}
#define TILE_CNT(F)    ((LAS int*)((F).lds + SMALL_OFF + 4096))
#define TILE_START(F)  ((LAS int*)((F).lds + SMALL_OFF + 4096) + 32)
#define TILE_E(F)      ((LAS unsigned char*)((LAS int*)((F).lds + SMALL_OFF + 4096) + 96))

__device__ __forceinline__ void p5b_gather(const Frame& F, const Args& a) {
    const int NT = build_tiles(F, a);
    const LAS int* cnt = TILE_CNT(F); const LAS int* tstart = TILE_START(F); const LAS unsigned char* tileE = TILE_E(F);
    const bf16* H2 = (const bf16*)(a.ws + WS_H); bf16* XG = (bf16*)(a.ws + WS_XG);
    const int* list = (const int*)(a.ws + WS_ROUTE + RT_LIST); const float* listg = (const float*)(a.ws + WS_ROUTE + RT_LISTG); float* rowg = (float*)(a.ws + WS_ROUTE + RT_ROWG);
    for (int r = F.gw; r < NT * 256; r += F.NGW) { const int T = r >> 8, e = tileE[T], pos = (T - tstart[e]) * 256 + (r & 255); const bool valid = pos < cnt[e];
        GAS v4u* dst = (GAS v4u*)(XG + (size_t)r * DM) + F.lane;
        if (valid) { const int tok = list[(size_t)e * CAP + pos]; const GAS v4u* src = (const GAS v4u*)(H2 + (size_t)tok * DM) + F.lane;
#pragma unroll
            for (int j = 0; j < 4; ++j) dst[64 * j] = src[64 * j];
            if (F.lane == 0) rowg[r] = listg[(size_t)e * CAP + pos]; }
        else {
#pragma unroll
            for (int j = 0; j < 4; ++j) dst[64 * j] = (v4u){0u, 0u, 0u, 0u};
            if (F.lane == 0) rowg[r] = 0.f; } }
}

__device__ __forceinline__ void p8_final(const Frame& F, const Args& a) {
    (void)build_tiles(F, a);
    const LAS int* tstart = TILE_START(F);
    const float* X1 = (const float*)(a.ws + WS_X1); const bf16* Y = (const bf16*)(a.ws + WS_Y);
    const int* tok_e = (const int*)(a.ws + WS_ROUTE + RT_TOKE); const int* tok_pos = (const int*)(a.ws + WS_ROUTE + RT_TOKPOS);
    const float* fn = a.in[I_FIN];
    for (int m = F.gw; m < NTOK; m += F.NGW) {
        f32x4 v[8]; const GAS f32x4* xr = (const GAS f32x4*)(X1 + (size_t)m * DM) + F.lane;
#pragma unroll
        for (int j = 0; j < 8; ++j) v[j] = xr[64 * j];
#pragma unroll
        for (int s = 0; s < 4; ++s) { const int e = tok_e[m * 4 + s], pos = tok_pos[m * 4 + s]; const size_t r = (size_t)tstart[e] * 256 + pos;
            const GAS v2u* yp = (const GAS v2u*)(Y + r * DM) + F.lane;
#pragma unroll
            for (int j = 0; j < 8; ++j) { const v2u q = yp[64 * j]; v[j].x += bflo(q.x); v[j].y += bfhi(q.x); v[j].z += bflo(q.y); v[j].w += bfhi(q.y); } }
        float ss = 0.f;
#pragma unroll
        for (int j = 0; j < 8; ++j) ss += (v[j].x * v[j].x + v[j].y * v[j].y) + (v[j].z * v[j].z + v[j].w * v[j].w);
        const float r = 1.0f / sqrtf(wave_sum(ss) * (1.f / DM) + EPS);
        GAS f32x4* op = (GAS f32x4*)(a.out + (size_t)m * DM) + F.lane;
#pragma unroll
        for (int j = 0; j < 8; ++j) { const f32x4 g = ((const GAS f32x4*)fn)[F.lane + 64 * j]; f32x4 o; o.x = v[j].x * r * g.x; o.y = v[j].y * r * g.y; o.z = v[j].z * r * g.z; o.w = v[j].w * r * g.w; op[64 * j] = o; }
    }
}

constexpr int N_PHASES = 10;
__global__ void __launch_bounds__(NTHREADS, 2) fwd_kernel(Args args) {
    extern __shared__ __attribute__((aligned(16))) unsigned char lds_raw[];
    Frame F;
    F.lds = (LAS unsigned char*)lds_raw;
    F.tid = threadIdx.x; F.lane = F.tid & 63; F.wave = __builtin_amdgcn_readfirstlane(F.tid >> 6);
    F.G = gridDim.x; F.gw = blockIdx.x * NWAVES + F.wave; F.NGW = F.G * NWAVES;
    volatile LAS unsigned* MISC = (volatile LAS unsigned*)(F.lds + MISC_OFF);
    if (F.tid < 16) MISC[F.tid] = 0u;
    __syncthreads();
    unsigned* ctl = (unsigned*)(args.ws + WS_CTL);
    const int lo = args.ph_lo, hi = args.ph_hi;
    const bool multi = (hi - lo) > 1;
    XcdBarrier bar; bar.bar = ctl + CW_BAR; bar.x = 0; bar.st = nullptr;
    if (multi) bar = xcd_barrier_post(ctl + CW_BAR, MISC + 8);
#ifndef PHMASK
#define PHMASK 0x3ff
#endif
#define IN(k) (((PHMASK >> (k)) & 1) && lo <= (k) && (k) < hi)
#define SEAM(k) do { if (IN(k) && IN((k) + 1)) xcd_barrier(bar); } while (0)

    if (IN(0)) { p0_prologue(F, args); }
    SEAM(0);
    if (IN(1)) {
        pg8::StaticOrder S; S.init(args.ws + WS_H, args.ws + WS_WIN_T, NTOK, INC, DM, F.G, (int)blockIdx.x);
        pg8::EpiZ E{(pg8::bf16_t*)(args.ws + WS_Z), INC};
        pg8::gemm_phase<pg8::EpiZ, pg8::StaticOrder>(F.lds + RING_OFF, DM, S, E);
    }
    SEAM(1);
    if (IN(2)) {
        for (int it = blockIdx.x; it < 256 + 128; it += F.G) { if (it < 256) hgrn_item(F, args, it); else gmlp_item(F, args, it - 256); }
    }
    SEAM(2);
    if (IN(3)) { p3_cat(F, args); }
    SEAM(3);
    if (IN(4)) {
        pg8::StaticOrder S; S.init(args.ws + WS_CAT, args.ws + WS_WOUT_T, NTOK, DM, DM, F.G, (int)blockIdx.x);
        pg8::EpiResF32 E{args.in[I_X], (float*)(args.ws + WS_X1), DM};
        pg8::gemm_phase<pg8::EpiResF32, pg8::StaticOrder>(F.lds + RING_OFF, DM, S, E);
    }
    SEAM(4);
    if (IN(5)) { p5_route(F, args); }
    SEAM(5);
    if (IN(6)) { p5b_gather(F, args); }
    SEAM(6);
    if (IN(7)) {
        const int NT = build_tiles(F, args);
        pg8::GroupedOrder S; S.init(args.ws + WS_XG, args.ws + WS_W1T, DM, 16, NT, TILE_E(F), F.G, (int)blockIdx.x);
        pg8::EpiSwiglu E{(pg8::bf16_t*)(args.ws + WS_ACT), args.in[I_B1]};
        pg8::gemm_phase<pg8::EpiSwiglu, pg8::GroupedOrder>(F.lds + RING_OFF, DM, S, E);
    }
    SEAM(7);
    if (IN(8)) {
        const int NT = build_tiles(F, args);
        pg8::GroupedOrder S; S.init(args.ws + WS_ACT, args.ws + WS_W2T, DEXP, 8, NT, TILE_E(F), F.G, (int)blockIdx.x);
        pg8::EpiY E{(pg8::bf16_t*)(args.ws + WS_Y), args.in[I_B2], (const float*)(args.ws + WS_ROUTE + RT_ROWG)};
        pg8::gemm_phase<pg8::EpiY, pg8::GroupedOrder>(F.lds + RING_OFF, DEXP, S, E);
    }
    SEAM(8);
    if (IN(9)) { p8_final(F, args); }
#undef IN
#undef SEAM
}

extern "C" void kernel_launch(void* const* d_in, const int* in_sizes, int n_in, void* d_out, int out_size, void* d_ws, size_t ws_size, hipStream_t stream) {
    static int grid = 0;
    if (grid == 0) {
        if (n_in != 20 || out_size != NTOK * DM || ws_size < WS_END) { fprintf(stderr, "kernel_launch: unexpected shapes (n_in %d out %d ws %zu)\n", n_in, out_size, ws_size); grid = -1; return; }
        int dev = 0, cus = 0, per_cu = 0;
        if (hipGetDevice(&dev) != hipSuccess || hipDeviceGetAttribute(&cus, hipDeviceAttributeMultiprocessorCount, dev) != hipSuccess) { grid = -1; return; }
        if (hipFuncSetAttribute((const void*)fwd_kernel, hipFuncAttributeMaxDynamicSharedMemorySize, LDS_BYTES) != hipSuccess) { fprintf(stderr, "kernel_launch: hipFuncSetAttribute failed\n"); grid = -1; return; }
        if (hipOccupancyMaxActiveBlocksPerMultiprocessor(&per_cu, (const void*)fwd_kernel, NTHREADS, LDS_BYTES) != hipSuccess || per_cu < 1) { fprintf(stderr, "kernel_launch: occupancy query says %d\n", per_cu); }
        (void)hipGetLastError();
        grid = cus;
    }
    if (grid < 0) return;
    (void)hipMemsetAsync((char*)d_ws + WS_CTL, 0, CTL_ZERO_BYTES, stream);
    Args a{};
    for (int i = 0; i < 20; ++i) a.in[i] = (const float*)d_in[i];
    a.out = (float*)d_out; a.ws = (unsigned char*)d_ws;
#if MK_N_LAUNCHES == 1
    a.ph_lo = 0; a.ph_hi = N_PHASES;
    hipLaunchKernelGGL(fwd_kernel, dim3(grid), dim3(NTHREADS), LDS_BYTES, stream, a);
#else
    for (int p = 0; p < N_PHASES; ++p) { a.ph_lo = p; a.ph_hi = p + 1; hipLaunchKernelGGL(fwd_kernel, dim3(grid), dim3(NTHREADS), LDS_BYTES, stream, a); }
#endif
}
```

```cpp
#include <hip/hip_runtime.h>
#include <cstdio>
#include <cstdint>

#ifndef MK_N_LAUNCHES
#define MK_N_LAUNCHES 1
#endif

namespace pg8 {
#define PG8_LAS __attribute__((address_space(3)))
typedef unsigned short bf16_t;
typedef short bf16x8 __attribute__((ext_vector_type(8)));
typedef float f32x4 __attribute__((ext_vector_type(4)));
typedef float f32x2 __attribute__((ext_vector_type(2)));
typedef unsigned u32x4 __attribute__((ext_vector_type(4)));
typedef unsigned u32x2 __attribute__((ext_vector_type(2)));
typedef int v4i_t __attribute__((ext_vector_type(4)));
typedef int v8i_t __attribute__((ext_vector_type(8)));
constexpr int BM = 256, BK = 64, HALF = 128, HTB = HALF * BK * 2, STAGE_BYTES = 8 * HTB, NXCD = 8, WGM = 8;

__host__ __device__ __forceinline__ int lds_byte(int r, int c) { const int st = (r >> 4) * 2 + (c >> 5), rr = r & 15, cc = c & 31, ob = rr * 64 + cc * 2; return st * 1024 + (ob ^ (((ob >> 9) & 1) << 5)); }
__host__ __device__ __forceinline__ void stage_rc(int b, int& R, int& C) { const int st = b / 1024, sb = b % 1024, swz = sb ^ (((sb >> 9) & 1) << 5); R = (st >> 1) * 16 + swz / 64; C = (st & 1) * 32 + (swz % 64) / 2; }
__host__ __device__ __forceinline__ int perm32(int rho) { const int n = rho >> 4, i = rho & 15; return 8 * (i >> 2) + 4 * n + (i & 3); }

struct Unit { int pm, pn, e, slot; };

struct StaticOrder {
    const char* A; const char* Bt; size_t tstep;
    int nM, nN, nwg, G, c;
    __device__ void init(const void* A_, const void* Bt_, int M, int N, int K, int G_, int c_) { A = (const char*)A_; Bt = (const char*)Bt_; tstep = (size_t)BM * K * 2; nM = M / BM; nN = N / BM; nwg = nM * nN; G = G_; c = c_; }
    __device__ bool next(int i, Unit& u) const {
        const long L = (long)i * G + c; if (L >= nwg) return false;
        int wgid = (int)L; { const int q = nwg / NXCD, r = nwg % NXCD, xcd = wgid % NXCD, off = wgid / NXCD; wgid = (xcd < r ? xcd * (q + 1) : r * (q + 1) + (xcd - r) * q) + off; }
        const int nig = WGM * nN, gid = wgid / nig, fm = gid * WGM, gsz = (nM - fm) < WGM ? (nM - fm) : WGM;
        u.pm = fm + ((wgid % nig) % gsz); u.pn = (wgid % nig) / gsz; u.e = 0; u.slot = i; return true;
    }
    __device__ __forceinline__ const char* abase(const Unit& u) const { return A + (size_t)u.pm * tstep; }
    __device__ __forceinline__ const char* bbase(const Unit& u) const { return Bt + (size_t)u.pn * tstep; }
};
struct GroupedOrder {
    const char* A; const char* Bt; size_t tstep, estep;
    const PG8_LAS unsigned char* tileE; const PG8_LAS unsigned short* tokidx; int NT, nN, nU, G, c, pw;
    const PG8_LAS unsigned short* tperm; int tbase, rot, slot0;
    __device__ void init(const void* A_, const void* Bt_, int K, int nN_, int NT_, const PG8_LAS unsigned char* tileE_, const PG8_LAS unsigned short* tperm_, int tbase_, int G_, int c_) {
        A = (const char*)A_; Bt = (const char*)Bt_; tstep = (size_t)BM * K * 2; estep = (size_t)nN_ * tstep; tileE = tileE_; tokidx = nullptr; NT = NT_; nN = nN_; nU = NT_ * nN_; G = G_; c = c_; pw = 4;
        tperm = tperm_; tbase = tbase_; rot = 0; slot0 = 0; }
    __device__ bool next(int i, Unit& u) const {
        int cp = ((G % 8 == 0) ? ((c % 8) * (G / 8) + c / 8) : c) - rot; if (cp < 0) cp += G;
        const int L = i * G + cp; if (L >= nU) return false;
        const int png = L / (NT * pw), rem = L % (NT * pw); u.pm = tperm[tbase + rem / pw]; u.pn = png * pw + (rem % pw); u.e = tileE[u.pm]; u.slot = slot0 + i; return true;
    }
    __device__ __forceinline__ const char* abase(const Unit& u) const { return tokidx ? A : A + (size_t)u.pm * tstep; }
    __device__ __forceinline__ const char* bbase(const Unit& u) const { return Bt + (size_t)u.e * estep + (size_t)u.pn * tstep; }
};

__device__ __forceinline__ unsigned cvt_pk_bf16(float lo, float hi) { unsigned r; asm volatile("v_cvt_pk_bf16_f32 %0, %1, %2" : "=v"(r) : "v"(lo), "v"(hi)); return r; }
__device__ __forceinline__ f32x2 gelu_pk(f32x2 v) {
    const f32x2 av = __builtin_elementwise_abs(v), d = av * 0.2316418882f + 1.0f;
    f32x2 t; t.x = __builtin_amdgcn_rcpf(d.x); t.y = __builtin_amdgcn_rcpf(d.y);
    f32x2 q = t * 0.5307027145f + (-0.7265760135f); q = q * t + 0.7107068705f; q = q * t + (-0.142248368f); q = q * t + 0.127414796f; q = q * t;
    const f32x2 s = (v * v) * (-0.72134752044f);
    f32x2 e; e.x = __builtin_amdgcn_exp2f(s.x); e.y = __builtin_amdgcn_exp2f(s.y);
    const f32x2 m = v * (q * e), r = v - m;
    f32x2 o; o.x = v.x < 0.f ? m.x : r.x; o.y = v.y < 0.f ? m.y : r.y; return o;
}
__device__ __forceinline__ float sigmoidf_fast(float x) { return __builtin_amdgcn_rcpf(1.0f + __builtin_amdgcn_exp2f(-1.44269504089f * x)); }
__device__ __forceinline__ float siluf_fast(float x) { return x * sigmoidf_fast(x); }


struct EpiZ {
    static constexpr bool PERM = true;
    bf16_t* O; int ldc;
    __device__ __forceinline__ void operator()(const f32x4 (&acc)[2][2][4][2], const Unit& u, int wr, int wc, int fr, int fq) const {
        const int row0 = u.pm * BM + wr * 64 + fr, col0 = u.pn * BM + wc * 32 + 8 * fq;
        const int act = (u.pn < 8) ? 1 : ((u.pn < 12 || u.pn >= 24) ? 2 : 0);
#pragma unroll
        for (int ai = 0; ai < 2; ++ai)
#pragma unroll
            for (int m = 0; m < 4; ++m) { bf16_t* rowp = O + (size_t)(row0 + ai * HALF + m * 16) * ldc + col0;
#pragma unroll
                for (int bj = 0; bj < 2; ++bj) { f32x4 v0 = acc[ai][bj][m][0], v1 = acc[ai][bj][m][1];
                    if (act == 1) { f32x2 a = gelu_pk((f32x2){v0[0], v0[1]}), b = gelu_pk((f32x2){v0[2], v0[3]}), c = gelu_pk((f32x2){v1[0], v1[1]}), d = gelu_pk((f32x2){v1[2], v1[3]});
                        v0 = (f32x4){a.x, a.y, b.x, b.y}; v1 = (f32x4){c.x, c.y, d.x, d.y}; }
                    else if (act == 2) {
#pragma unroll
                        for (int j = 0; j < 4; ++j) { v0[j] = siluf_fast(v0[j]); v1[j] = siluf_fast(v1[j]); } }
                    u32x4 w; w.x = cvt_pk_bf16(v0[0], v0[1]); w.y = cvt_pk_bf16(v0[2], v0[3]); w.z = cvt_pk_bf16(v1[0], v1[1]); w.w = cvt_pk_bf16(v1[2], v1[3]);
                    *(u32x4*)(rowp + bj * HALF) = w; } }
    }
};
struct EpiBf16Plain {
    static constexpr bool PERM = true;
    bf16_t* O; int ldc;
    __device__ __forceinline__ void operator()(const f32x4 (&acc)[2][2][4][2], const Unit& u, int wr, int wc, int fr, int fq) const {
        const int row0 = u.pm * BM + wr * 64 + fr, col0 = u.pn * BM + wc * 32 + 8 * fq;
#pragma unroll
        for (int ai = 0; ai < 2; ++ai)
#pragma unroll
            for (int m = 0; m < 4; ++m) { bf16_t* rowp = O + (size_t)(row0 + ai * HALF + m * 16) * ldc + col0;
#pragma unroll
                for (int bj = 0; bj < 2; ++bj) { const f32x4 v0 = acc[ai][bj][m][0], v1 = acc[ai][bj][m][1];
                    u32x4 w; w.x = cvt_pk_bf16(v0[0], v0[1]); w.y = cvt_pk_bf16(v0[2], v0[3]); w.z = cvt_pk_bf16(v1[0], v1[1]); w.w = cvt_pk_bf16(v1[2], v1[3]);
                    *(u32x4*)(rowp + bj * HALF) = w; } }
    }
};
constexpr float W8_SCALE = 32.0f, W8_INV = 1.0f / 32.0f;
__device__ __forceinline__ unsigned cvt4_fp8(float a, float b, float c, float d) { int r = 0; r = __builtin_amdgcn_cvt_pk_fp8_f32(a, b, r, false); r = __builtin_amdgcn_cvt_pk_fp8_f32(c, d, r, true); return (unsigned)r; }
template <bool HALFM = false>
struct EpiSwigluT {
    static constexpr bool PERM = true;
    unsigned char* O; const float* b1;
    __device__ __forceinline__ void operator()(const f32x4 (&acc)[2][2][4][2], const Unit& u, int wr, int wc, int fr, int fq) const {
        const int row0 = u.pm * BM + wr * 64 + fr, j0 = u.pn * HALF + wc * 32 + 8 * fq;
        const float* bp = b1 + (size_t)u.e * 4096 + 2 * j0;
        const f32x4 q0 = *(const f32x4*)(bp), q1 = *(const f32x4*)(bp + 4), q2 = *(const f32x4*)(bp + 8), q3 = *(const f32x4*)(bp + 12);
        const f32x4 bg0 = (f32x4){q0[0], q0[2], q1[0], q1[2]}, bl0 = (f32x4){q0[1], q0[3], q1[1], q1[3]};
        const f32x4 bg1 = (f32x4){q2[0], q2[2], q3[0], q3[2]}, bl1 = (f32x4){q2[1], q2[3], q3[1], q3[3]};
#pragma unroll
        for (int ai = 0; ai < (HALFM ? 1 : 2); ++ai)
#pragma unroll
            for (int m = 0; m < 4; ++m) { unsigned char* rowp = O + (size_t)(row0 + ai * HALF + m * 16) * 2048 + j0;
                f32x4 o[2];
#pragma unroll
                for (int n = 0; n < 2; ++n) { const f32x4 g = acc[ai][0][m][n] * W8_INV + (n ? bg1 : bg0), l = acc[ai][1][m][n] * W8_INV + (n ? bl1 : bl0);
#pragma unroll
                    for (int j = 0; j < 4; ++j) { const float gg = fminf(g[j], 7.0f), ll = fminf(fmaxf(l[j], -7.0f), 7.0f);
                        o[n][j] = gg * sigmoidf_fast(1.702f * gg) * (ll + 1.0f); } }
                u32x2 w; w.x = cvt4_fp8(o[0][0], o[0][1], o[0][2], o[0][3]); w.y = cvt4_fp8(o[1][0], o[1][1], o[1][2], o[1][3]);
                *(u32x2*)rowp = w; }
    }
};
typedef EpiSwigluT<false> EpiSwiglu;
template <bool HALFM = false>
struct EpiYT {
    static constexpr bool PERM = true;
    unsigned char* O; const float* b2; const float* listg; const PG8_LAS int* tstart; int cap;
    __device__ __forceinline__ void operator()(const f32x4 (&acc)[2][2][4][2], const Unit& u, int wr, int wc, int fr, int fq) const {
        const int rl0 = wr * 64 + fr, row0 = u.pm * BM + rl0, col0 = u.pn * BM + wc * 32 + 8 * fq;
        const float* bp = b2 + (size_t)u.e * 2048 + col0;
        const float* gp = listg + (size_t)u.e * cap + (size_t)(u.pm - tstart[u.e]) * 256 + rl0;
        f32x4 bv[2][2]; float gts[2][4];
#pragma unroll
        for (int bj = 0; bj < 2; ++bj)
#pragma unroll
            for (int n = 0; n < 2; ++n) bv[bj][n] = *(const f32x4*)(bp + bj * HALF + 4 * n) * W8_SCALE;
#pragma unroll
        for (int ai = 0; ai < (HALFM ? 1 : 2); ++ai)
#pragma unroll
            for (int m = 0; m < 4; ++m) gts[ai][m] = gp[ai * HALF + m * 16] * W8_INV;
#pragma unroll
        for (int ai = 0; ai < (HALFM ? 1 : 2); ++ai)
#pragma unroll
            for (int m = 0; m < 4; ++m) { const int r = row0 + ai * HALF + m * 16; const float gt = gts[ai][m]; unsigned char* rowp = O + (size_t)r * 2048 + col0;
#pragma unroll
                for (int bj = 0; bj < 2; ++bj) { const f32x4 v0 = (acc[ai][bj][m][0] + bv[bj][0]) * gt, v1 = (acc[ai][bj][m][1] + bv[bj][1]) * gt;
                    u32x2 w; w.x = cvt4_fp8(v0[0], v0[1], v0[2], v0[3]); w.y = cvt4_fp8(v1[0], v1[1], v1[2], v1[3]);
                    *(u32x2*)(rowp + bj * HALF) = w; } }
    }
};
typedef EpiYT<false> EpiY;

template <class Epi, class Sched, bool FP8 = false, bool GATHER = false, bool ALIGN_EPI = true, bool HALFM = false>
__device__ __forceinline__ void gemm_phase(PG8_LAS unsigned char* lds, const int K, const Sched& S, const Epi& E) {
    const int tid = threadIdx.x, wid = __builtin_amdgcn_readfirstlane(tid >> 6), lane = tid & 63, wr = wid >> 2, wc = wid & 3, fr = lane & 15, fq = lane >> 4;
    const int nt = K / BK;
    unsigned voffA[2][2], voffAn[2][2], voffB[2]; int stR[2], stC[2];
#pragma unroll
    for (int i = 0; i < 2; ++i) { int R, C; stage_rc(tid * 16 + i * 8192, R, C); const int Rb = Epi::PERM ? ((R & ~31) + perm32(R & 31)) : R; stR[i] = R; stC[i] = C;
        voffB[i] = (unsigned)(Rb * K + C) * 2u;
#pragma unroll
        for (int h = 0; h < 2; ++h) { voffA[h][i] = (unsigned)((R + h * HALF) * K + C) * 2u; voffAn[h][i] = voffA[h][i]; } }
#define PG8_GATHER_OFFS(dst, u) do { if constexpr (GATHER) { const PG8_LAS unsigned short* _tk = S.tokidx + (u).slot * 256; _Pragma("unroll") for (int h = 0; h < 2; ++h) _Pragma("unroll") for (int i = 0; i < 2; ++i) \
        dst[h][i] = ((unsigned)_tk[stR[i] + h * HALF] * (unsigned)K + (unsigned)stC[i]) * 2u; } } while (0)
    const size_t kstep = (size_t)(BK * 2);
    const size_t hstep = (size_t)HALF * K * 2;
    const unsigned ldsw = (unsigned)wid * 1024u;
    const int aoff = lds_byte(wr * 64 + fr, fq * 8), boff = lds_byte(wc * 32 + fr, fq * 8);
#define PG8_SA(b, h) (((b) * 2 + (h)) * HTB)
#define PG8_SB(b, h) ((4 + (b) * 2 + (h)) * HTB)
#define PG8_STAGE(bufoff, gbase, voff) do { _Pragma("unroll") for (int _i = 0; _i < 2; ++_i) \
        __builtin_amdgcn_global_load_lds((const unsigned*)((const char*)(gbase) + (voff)[_i]), (PG8_LAS unsigned*)(lds + (bufoff) + ldsw + _i * 8192), 16, 0, 0); } while (0)
#define PG8_LD16(off) (*(const PG8_LAS bf16x8*)(lds + (off)))
#define PG8_CAT8(x, y) __builtin_shufflevector(__builtin_bit_cast(v4i_t, (x)), __builtin_bit_cast(v4i_t, (y)), 0, 1, 2, 3, 4, 5, 6, 7)
#define PG8_LDA(dst, b, h) do { if constexpr (FP8) { _Pragma("unroll") for (int m = 0; m < 4; ++m) dst##8[m] = PG8_CAT8(PG8_LD16(PG8_SA(b, h) + aoff + m * 2048), PG8_LD16(PG8_SA(b, h) + aoff + m * 2048 + 1024)); } \
        else { _Pragma("unroll") for (int m = 0; m < 4; ++m) _Pragma("unroll") for (int k = 0; k < 2; ++k) dst[m][k] = PG8_LD16(PG8_SA(b, h) + aoff + m * 2048 + k * 1024); } } while (0)
#define PG8_LDB(dst, b, h) do { if constexpr (FP8) { _Pragma("unroll") for (int n = 0; n < 2; ++n) dst##8[n] = PG8_CAT8(PG8_LD16(PG8_SB(b, h) + boff + n * 2048), PG8_LD16(PG8_SB(b, h) + boff + n * 2048 + 1024)); } \
        else { _Pragma("unroll") for (int n = 0; n < 2; ++n) _Pragma("unroll") for (int k = 0; k < 2; ++k) dst[n][k] = PG8_LD16(PG8_SB(b, h) + boff + n * 2048 + k * 1024); } } while (0)
#define PG8_MMA(ai, bj, At, Bt) do { __builtin_amdgcn_s_setprio(1); \
        if constexpr (FP8) { _Pragma("unroll") for (int m = 0; m < 4; ++m) _Pragma("unroll") for (int n = 0; n < 2; ++n) { \
            asm volatile("v_mfma_f32_16x16x128_f8f6f4 %0, %1, %2, %0" : "+v"(acc[ai][bj][m][n]) : "v"(Bt##8[n]), "v"(At##8[m])); } } \
        else { _Pragma("unroll") for (int m = 0; m < 4; ++m) _Pragma("unroll") for (int n = 0; n < 2; ++n) _Pragma("unroll") for (int k = 0; k < 2; ++k) \
            acc[ai][bj][m][n] = __builtin_amdgcn_mfma_f32_16x16x32_bf16(Bt[n][k], At[m][k], acc[ai][bj][m][n], 0, 0, 0); } \
        __builtin_amdgcn_s_setprio(0); } while (0)
#define PG8_WAIT_V(n) asm volatile("s_waitcnt vmcnt(" #n ")" ::: "memory")
#define PG8_WAIT_L(n) asm volatile("s_waitcnt lgkmcnt(" #n ")" ::: "memory")
#define PG8_WAIT_VH do { if constexpr (HALFM) PG8_WAIT_V(6); else PG8_WAIT_V(8); } while (0)
#define PG8_BAR __builtin_amdgcn_s_barrier()
#define PG8_SCHED __builtin_amdgcn_sched_barrier(0)
    Unit cur, nxt; int ui = 0;
    if (!S.next(0, cur)) return;
    f32x4 acc[2][2][4][2];
#pragma unroll
    for (int a = 0; a < 2; ++a)
#pragma unroll
        for (int b = 0; b < 2; ++b)
#pragma unroll
            for (int m = 0; m < 4; ++m)
#pragma unroll
                for (int n = 0; n < 2; ++n) acc[a][b][m][n] = (f32x4){0.f, 0.f, 0.f, 0.f};
    bf16x8 At[4][2], B0[2][2], B1[2][2]; v8i_t At8[4], B08[2], B18[2];
    const char* cA = S.abase(cur); const char* cB = S.bbase(cur);
    PG8_GATHER_OFFS(voffA, cur);
    PG8_STAGE(PG8_SB(0, 0), cB, voffB); PG8_STAGE(PG8_SB(0, 1), cB + hstep, voffB); PG8_STAGE(PG8_SA(0, 0), cA, voffA[0]); if constexpr (!HALFM) PG8_STAGE(PG8_SA(0, 1), cA, voffA[1]);
    if (wr == 1) PG8_BAR;
    if constexpr (HALFM) PG8_WAIT_V(0); else PG8_WAIT_V(2);
    PG8_BAR;
    PG8_STAGE(PG8_SB(1, 0), cB + kstep, voffB); PG8_STAGE(PG8_SA(1, 0), cA + kstep, voffA[0]); PG8_STAGE(PG8_SB(1, 1), cB + hstep + kstep, voffB);
    PG8_WAIT_V(6); PG8_BAR;
    for (;;) {
        const bool has_next = S.next(ui + 1, nxt);
        const char* nA = has_next ? S.abase(nxt) : cA; const char* nB = has_next ? S.bbase(nxt) : cB;
        if constexpr (GATHER) { if (has_next) PG8_GATHER_OFFS(voffAn, nxt); else {
#pragma unroll
            for (int h = 0; h < 2; ++h)
#pragma unroll
                for (int i = 0; i < 2; ++i) voffAn[h][i] = voffA[h][i]; } }
        for (int t = 0; t < nt; t += 2) {
            const bool last = (t == nt - 2);
            const char* a1 = cA + (size_t)(t + 1) * kstep;
            const char* a2 = last ? nA : cA + (size_t)(t + 2) * kstep; const char* b2 = last ? nB : cB + (size_t)(t + 2) * kstep;
            const char* a3 = a2 + kstep; const char* b3 = b2 + kstep;
            unsigned vA2[2][2];
#pragma unroll
            for (int h = 0; h < 2; ++h)
#pragma unroll
                for (int i = 0; i < 2; ++i) vA2[h][i] = (GATHER && last) ? voffAn[h][i] : voffA[h][i];
            PG8_LDB(B0, 0, 0); PG8_LDB(B1, 0, 1); PG8_SCHED; PG8_LDA(At, 0, 0); if constexpr (!HALFM) PG8_STAGE(PG8_SA(1, 1), a1, voffA[1]);
            PG8_WAIT_VH; PG8_WAIT_L(0); PG8_BAR; PG8_MMA(0, 0, At, B0); PG8_MMA(0, 1, At, B1); PG8_BAR; PG8_SCHED;
            if constexpr (!HALFM) PG8_LDA(At, 0, 1); PG8_STAGE(PG8_SB(0, 0), b2, voffB); PG8_STAGE(PG8_SB(0, 1), b2 + hstep, voffB); PG8_STAGE(PG8_SA(0, 0), a2, vA2[0]);
            PG8_WAIT_VH; PG8_WAIT_L(0); PG8_BAR; if constexpr (!HALFM) { PG8_MMA(1, 0, At, B0); PG8_MMA(1, 1, At, B1); } PG8_BAR; PG8_SCHED;
            PG8_LDB(B0, 1, 0); PG8_LDB(B1, 1, 1); PG8_SCHED; PG8_LDA(At, 1, 0); if constexpr (!HALFM) PG8_STAGE(PG8_SA(0, 1), a2, vA2[1]);
            PG8_WAIT_VH; PG8_WAIT_L(0); PG8_BAR; PG8_MMA(0, 0, At, B0); PG8_MMA(0, 1, At, B1); PG8_BAR; PG8_SCHED;
            if constexpr (!HALFM) PG8_LDA(At, 1, 1); PG8_STAGE(PG8_SB(1, 0), b3, voffB); PG8_STAGE(PG8_SB(1, 1), b3 + hstep, voffB); PG8_STAGE(PG8_SA(1, 0), a3, vA2[0]);
            PG8_WAIT_VH; PG8_WAIT_L(0); PG8_BAR; if constexpr (!HALFM) { PG8_MMA(1, 0, At, B0); PG8_MMA(1, 1, At, B1); } PG8_BAR; PG8_SCHED;
        }
        if constexpr (ALIGN_EPI) { if (wr == 0) PG8_BAR; }
        if constexpr (FP8) {
            asm volatile("s_nop 15\n\ts_nop 3" ::: "memory");
#pragma unroll
            for (int a = 0; a < 2; ++a)
#pragma unroll
                for (int b = 0; b < 2; ++b)
                    asm volatile("" : "+v"(acc[a][b][0][0]), "+v"(acc[a][b][0][1]), "+v"(acc[a][b][1][0]), "+v"(acc[a][b][1][1]), "+v"(acc[a][b][2][0]), "+v"(acc[a][b][2][1]), "+v"(acc[a][b][3][0]), "+v"(acc[a][b][3][1]));
        }
        E(acc, cur, wr, wc, fr, fq);
        if (!has_next) break;
#pragma unroll
        for (int a = 0; a < 2; ++a)
#pragma unroll
            for (int b = 0; b < 2; ++b)
#pragma unroll
                for (int m = 0; m < 4; ++m)
#pragma unroll
                    for (int n = 0; n < 2; ++n) acc[a][b][m][n] = (f32x4){0.f, 0.f, 0.f, 0.f};
        cur = nxt; cA = nA; cB = nB; ++ui;
        if constexpr (GATHER) {
#pragma unroll
            for (int h = 0; h < 2; ++h)
#pragma unroll
                for (int i = 0; i < 2; ++i) voffA[h][i] = voffAn[h][i]; }
        if constexpr (ALIGN_EPI) { if (wr == 1) PG8_BAR; }
    }
    PG8_WAIT_V(0);
    if constexpr (!ALIGN_EPI) { if (wr == 0) PG8_BAR; }
    PG8_BAR;
#undef PG8_SA
#undef PG8_SB
#undef PG8_STAGE
#undef PG8_LDA
#undef PG8_LDB
#undef PG8_MMA
#undef PG8_CAT8
#undef PG8_GATHER_OFFS
#undef PG8_LD16
#undef PG8_WAIT_V
#undef PG8_WAIT_L
#undef PG8_WAIT_VH
#undef PG8_BAR
#undef PG8_SCHED
}
}

constexpr int NB = 8, SEQ = 2048, DM = 2048, NTOK = NB * SEQ, INC = 7168, DA = 1024, NEXP = 32, TOPK = 4, DEXP = 2048;
constexpr int CAP = 16384;
constexpr int MAXT = NTOK * TOPK / 256 + NEXP;
constexpr int PROWS = MAXT * 256;
constexpr float EPS = 1e-5f;
constexpr int ZU = 0, ZV = 1024, ZQ = 2048, ZFF = 3072, ZFB = 4096, ZI = 5120, ZG = 6144;
constexpr int NWAVES = 8, NTHREADS = 512;

constexpr size_t MiB = 1u << 20;
constexpr size_t WS_CTL = 0, CTL_ZERO_BYTES = 64 * 1024;
constexpr size_t WS_WIN_T = 1 * MiB;
constexpr size_t WS_WOUT_T = 29 * MiB;
constexpr size_t WS_WRT = 37 * MiB;
constexpr size_t WS_H = 38 * MiB;
constexpr size_t WS_Z = 102 * MiB;
constexpr size_t WS_ARAW = 326 * MiB;
constexpr size_t WS_OF = 358 * MiB;
constexpr size_t WS_OB = 422 * MiB;
constexpr size_t WS_CAT = 486 * MiB;
constexpr size_t WS_X1 = 550 * MiB;
constexpr size_t WS_ROUTE = 678 * MiB;
constexpr size_t RT_TOKE = 0, RT_TOKPOS = 256 * 1024, RT_ROWG = 512 * 1024, RT_LIST = 1 * MiB, RT_LISTG = 3 * MiB, RT_END = 5 * MiB;
static_assert(RT_ROWG + (size_t)PROWS * 4 <= RT_LIST && RT_LIST + (size_t)NEXP * CAP * 4 <= RT_LISTG && RT_LISTG + (size_t)NEXP * CAP * 4 <= RT_END && RT_END <= 8 * MiB, "route map");
constexpr size_t WS_XG = 686 * MiB;
constexpr size_t WS_ACT = 830 * MiB;
constexpr size_t WS_Y = 974 * MiB;
constexpr size_t WS_W1T = 1262 * MiB;
constexpr size_t WS_W2T = 1518 * MiB;
constexpr size_t WS_END = 1646 * MiB;
static_assert(WS_WIN_T + (size_t)INC * DM * 2 <= WS_WOUT_T && WS_WOUT_T + (size_t)DM * DM * 2 <= WS_WRT && WS_WRT + (size_t)NEXP * DM * 4 <= WS_H && WS_H + (size_t)NTOK * DM * 2 <= WS_Z &&
              WS_Z + (size_t)NTOK * INC * 2 <= WS_ARAW && WS_ARAW + (size_t)NTOK * DA * 2 <= WS_OF && WS_OF + (size_t)NTOK * DA * 4 <= WS_OB && WS_OB + (size_t)NTOK * DA * 4 <= WS_CAT &&
              WS_CAT + (size_t)NTOK * DM * 2 <= WS_X1 && WS_X1 + (size_t)NTOK * DM * 4 <= WS_ROUTE && WS_ROUTE + 8 * MiB <= WS_XG && WS_XG + (size_t)PROWS * DM <= WS_ACT &&
              WS_ACT + (size_t)PROWS * DEXP <= WS_Y && WS_Y + (size_t)PROWS * DM * 2 <= WS_W1T && WS_W1T + (size_t)NEXP * 4096 * DM <= WS_W2T && WS_W2T + (size_t)NEXP * DM * DEXP <= WS_END, "ws map");
constexpr int CW_BAR = 4096;
constexpr int CW_CNT = 8192;

constexpr int RING_OFF = 0, RING_BYTES = 131072;
constexpr int LDS_BYTES = 163840;
constexpr int MISC_OFF = LDS_BYTES - 64;
constexpr int SMALL_OFF = RING_BYTES, SMALL_BYTES = MISC_OFF - RING_BYTES;
constexpr int TILES_OFF = SMALL_OFF;
constexpr int TOKIDX_OFF = SMALL_OFF + 1024;
constexpr int MAXU = 60;
constexpr int TPERM_OFF = TOKIDX_OFF + MAXU * 512;
static_assert(TPERM_OFF + 2 * 288 <= MISC_OFF, "LDS map");
#define LBAR() do { asm volatile("s_waitcnt lgkmcnt(0)" ::: "memory"); __builtin_amdgcn_s_barrier(); asm volatile("" ::: "memory"); } while (0)

#define GAS __attribute__((address_space(1)))
#define LAS __attribute__((address_space(3)))
typedef unsigned short bf16;
typedef unsigned v4u __attribute__((ext_vector_type(4)));
typedef unsigned v2u __attribute__((ext_vector_type(2)));
typedef float f32x4 __attribute__((ext_vector_type(4)));
typedef float f32x2t __attribute__((ext_vector_type(2)));
#define LDS_WAIT() asm volatile("s_waitcnt lgkmcnt(0)" ::: "memory")
#define VM_WAIT() asm volatile("s_waitcnt vmcnt(0)" ::: "memory")
__device__ __forceinline__ unsigned f2bf(float f) { unsigned u = __builtin_bit_cast(unsigned, f); return (u + 0x7fffu + ((u >> 16) & 1u)) >> 16; }
typedef __bf16 bf16x2_t __attribute__((ext_vector_type(2)));
__device__ __forceinline__ unsigned pk2(float lo, float hi) { const f32x2t v = {lo, hi}; const bf16x2_t b = __builtin_convertvector(v, bf16x2_t); return __builtin_bit_cast(unsigned, b); }
__device__ __forceinline__ float bf2f(unsigned short b) { return __builtin_bit_cast(float, (unsigned)b << 16); }
__device__ __forceinline__ float bflo(unsigned w) { return __builtin_bit_cast(float, w << 16); }
__device__ __forceinline__ float bfhi(unsigned w) { return __builtin_bit_cast(float, w & 0xffff0000u); }
__device__ __forceinline__ void unpack16(const v4u q0, const v4u q1, float (&x)[16]) {
    x[0] = bflo(q0.x); x[1] = bfhi(q0.x); x[2] = bflo(q0.y); x[3] = bfhi(q0.y); x[4] = bflo(q0.z); x[5] = bfhi(q0.z); x[6] = bflo(q0.w); x[7] = bfhi(q0.w);
    x[8] = bflo(q1.x); x[9] = bfhi(q1.x); x[10] = bflo(q1.y); x[11] = bfhi(q1.y); x[12] = bflo(q1.z); x[13] = bfhi(q1.z); x[14] = bflo(q1.w); x[15] = bfhi(q1.w);
}
__device__ __forceinline__ float wave_sum(float v) {
#pragma unroll
    for (int o = 1; o < 64; o <<= 1) v += __shfl_xor(v, o);
    return v;
}

#define XB_TMO      128
#define XB_XCNT(j)  (256  + 64 * (j))
#define XB_XSUB(j)  (1280 + 64 * (j))
#define XB_XGEN(j)  (2304 + 64 * (j))
#define XB_TOP      3328
#define XB_TOPGEN   3392
#define XCD_BAR_WORDS 3456
#define XB_SPIN_CAP (1u << 18)
__device__ __forceinline__ unsigned xb_ld(unsigned* p)              { return __hip_atomic_load(p, __ATOMIC_RELAXED, __HIP_MEMORY_SCOPE_AGENT); }
__device__ __forceinline__ unsigned xb_add(unsigned* p, unsigned v) { return __hip_atomic_fetch_add(p, v, __ATOMIC_RELAXED, __HIP_MEMORY_SCOPE_AGENT); }
__device__ __forceinline__ unsigned xb_xcc_id() { return (unsigned)__builtin_amdgcn_s_getreg((3 << 11) | 20) & 0xFu; }
#define XB_SPIN(cond, bar) do { unsigned _sp = 0; while (cond) { __builtin_amdgcn_s_sleep(1); \
    if ((++_sp & 255u) == 0u) { if (xb_ld(&(bar)[XB_TMO])) break; if (_sp > XB_SPIN_CAP) { atomicAdd(&(bar)[XB_TMO], 1u); break; } } } } while (0)
struct XcdBarrier { unsigned* bar; unsigned x; volatile LAS unsigned* st; };
__device__ __forceinline__ XcdBarrier xcd_barrier_post(unsigned* bar, volatile LAS unsigned* st) {
    XcdBarrier b; b.bar = bar; b.x = xb_xcc_id(); b.st = st;
    if (threadIdx.x == 0) (void)xb_add(&bar[XB_XCNT(b.x)], 1u);
    return b;
}
__device__ __forceinline__ void xcd_barrier_complete(unsigned* bar, unsigned x, unsigned& nloc, unsigned& nx) {
    const unsigned G = gridDim.x * gridDim.y * gridDim.z;
    unsigned sum, cnt, mine, sp = 0u;
    for (;;) {
        sum = 0u; cnt = 0u; mine = 0u;
#pragma unroll
        for (unsigned j = 0; j < 16; ++j) { const unsigned c = xb_ld(&bar[XB_XCNT(j)]); sum += c; cnt += (c > 0u) ? 1u : 0u; mine = (j == x) ? c : mine; }
        if (sum == G) break;
        __builtin_amdgcn_s_sleep(1);
        if ((++sp & 255u) == 0u) { if (xb_ld(&bar[XB_TMO])) break; if (sp > XB_SPIN_CAP) { atomicAdd(&bar[XB_TMO], 1u); break; } }
    }
    nloc = mine > 0u ? mine : 1u; nx = cnt > 0u ? cnt : 1u;
}
__device__ __forceinline__ void xcd_barrier(const XcdBarrier& b) {
    asm volatile("s_waitcnt vmcnt(0)" ::: "memory");
    __syncthreads();
    if (threadIdx.x == 0) {
        unsigned* bar = b.bar;
        __builtin_amdgcn_s_waitcnt(0);
        unsigned nloc = b.st[0], nx = b.st[1];
        if (nloc == 0u) { xcd_barrier_complete(bar, b.x, nloc, nx); b.st[0] = nloc; b.st[1] = nx; }
        const unsigned old = xb_add(&bar[XB_XSUB(b.x)], 1u);
        const unsigned gen = old / nloc;
        if (old + 1u == (gen + 1u) * nloc) {
            __builtin_amdgcn_fence(__ATOMIC_RELEASE, "agent");
            asm volatile("s_waitcnt vmcnt(0)" ::: "memory");
            const unsigned og = xb_add(&bar[XB_TOP], 1u);
            const unsigned tg = og / nx;
            if (og + 1u == (tg + 1u) * nx) xb_add(&bar[XB_TOPGEN], 1u);
            else XB_SPIN(xb_ld(&bar[XB_TOPGEN]) == tg, bar);
            __builtin_amdgcn_fence(__ATOMIC_ACQUIRE, "agent");
            xb_add(&bar[XB_XGEN(b.x)], 1u);
            asm volatile("s_waitcnt vmcnt(0)" ::: "memory");
        } else {
            XB_SPIN(xb_ld(&bar[XB_XGEN(b.x)]) == gen, bar);
            __builtin_amdgcn_fence(__ATOMIC_ACQUIRE, "agent");
            asm volatile("s_waitcnt vmcnt(0)" ::: "memory");
        }
    }
    __syncthreads();
}

struct Args { const float* in[20]; float* out; unsigned char* ws; int ph_lo, ph_hi; };
enum { I_X = 0, I_MIXN, I_WIN, I_LNW, I_LNB, I_WSP, I_BSP, I_GON, I_LBF, I_LBB, I_HON, I_WOUT, I_MOEN, I_WR, I_BR, I_W1, I_B1, I_W2, I_B2, I_FIN };

struct Frame {
    LAS unsigned char* lds;
    int tid, lane, wave, G, gw, NGW;
};

__device__ __forceinline__ void p0_transpose_item(const float* W, int K, int N, bf16* WT, LAS float* scr, int item, int lane) {
    const int nblk = N / 32, kb = item / nblk, nb = item % nblk, k0 = 64 * kb, n0 = 32 * nb;
#pragma unroll 8
    for (int i = 0; i < 32; ++i) { const int kk = 2 * i + (lane >> 5); scr[kk * 33 + (lane & 31)] = W[(size_t)(k0 + kk) * N + n0 + (lane & 31)]; }
    LDS_WAIT(); asm volatile("" ::: "memory");
    const int c = lane & 7;
#pragma unroll
    for (int j = 0; j < 4; ++j) { const int n = (lane >> 3) + 8 * j; const LAS float* s = scr + (8 * c) * 33 + n;
        v4u o; o.x = pk2(s[0 * 33], s[1 * 33]); o.y = pk2(s[2 * 33], s[3 * 33]); o.z = pk2(s[4 * 33], s[5 * 33]); o.w = pk2(s[6 * 33], s[7 * 33]);
        *(GAS v4u*)(WT + (size_t)(n0 + n) * K + k0 + 8 * c) = o; }
    LDS_WAIT(); asm volatile("" ::: "memory");
}
template <bool PERMW1>
__device__ __forceinline__ void p0_block_tile_fp8(const float* W, int K, int N, unsigned char* WT, LAS float* scr, int tile, int tid) {
    const int nblk = N / 256, kb = tile / nblk, nb = tile % nblk, k0 = 128 * kb, n0 = 256 * nb;
    const int r = tid >> 6, nq = tid & 63;
#pragma unroll
    for (int i = 0; i < 16; ++i) { const int kk = 8 * i + r; const f32x4 v = *(const GAS f32x4*)(W + (size_t)(k0 + kk) * N + n0 + 4 * nq);
        *(LAS f32x4*)(scr + kk * 260 + 16 * (kk >> 6) + 4 * nq) = v; }
    LBAR();
    { const int n = tid >> 1, ch = tid & 1; const LAS float* s = scr + (64 * ch) * 260 + 16 * ch + n;
      const int ng = n0 + n; const int drow = PERMW1 ? ((ng >> 8) * 256 + (ng & 1) * 128 + ((ng & 255) >> 1)) : ng;
      GAS v4u* dst = (GAS v4u*)(WT + (size_t)drow * K + k0 + 64 * ch);
#pragma unroll
      for (int q = 0; q < 4; ++q) { float f[16];
#pragma unroll
          for (int i = 0; i < 16; ++i) f[i] = s[(16 * q + i) * 260] * pg8::W8_SCALE;
          v4u o; o.x = pg8::cvt4_fp8(f[0], f[1], f[2], f[3]); o.y = pg8::cvt4_fp8(f[4], f[5], f[6], f[7]); o.z = pg8::cvt4_fp8(f[8], f[9], f[10], f[11]); o.w = pg8::cvt4_fp8(f[12], f[13], f[14], f[15]);
          dst[q] = o; } }
    LBAR();
}
constexpr int P0_TILE_BYTES = (128 * 260 + 16) * 4;
struct P0Tile { const float* W; unsigned char* WT; int K, N, k0, n0; bool perm; };
__device__ __forceinline__ void rms_row_to_bf16(const float* xrow, const float* w, bf16* orow, int lane) {
    const GAS f32x4* xr = (const GAS f32x4*)xrow + lane; const GAS f32x4* wr = (const GAS f32x4*)w + lane;
    f32x4 v[8]; float s = 0.f;
#pragma unroll
    for (int j = 0; j < 8; ++j) { v[j] = xr[64 * j]; s += (v[j].x * v[j].x + v[j].y * v[j].y) + (v[j].z * v[j].z + v[j].w * v[j].w); }
    const float r = 1.0f / sqrtf(wave_sum(s) * (1.f / DM) + EPS);
    GAS v2u* o8 = (GAS v2u*)orow + lane;
#pragma unroll
    for (int j = 0; j < 8; ++j) { const f32x4 g = wr[64 * j]; v2u o; o.x = pk2(v[j].x * r * g.x, v[j].y * r * g.y); o.y = pk2(v[j].z * r * g.z, v[j].w * r * g.w); o8[64 * j] = o; }
}
constexpr int P0_T_E1 = (DM / 128) * (4096 / 256), P0_T_E2 = (DEXP / 128) * (DM / 256);
constexpr int P0_NTILES = NEXP * P0_T_E1 + NEXP * P0_T_E2;
constexpr int P0_LATE_TILES = 896;
constexpr int P1_GEMM_WGS = 180, P1_CONV_PER_WG = 132;
constexpr int P1_CONV_TILES = (256 - P1_GEMM_WGS) * P1_CONV_PER_WG, P0_PRE_TILES = P0_NTILES - P0_LATE_TILES - P1_CONV_TILES;
__device__ __forceinline__ P0Tile p0_tile_decode(const Args& a, int r) {
    P0Tile t;
    if (r < NEXP * P0_T_E1) { const int e = r / P0_T_E1, q = r % P0_T_E1; t.W = a.in[I_W1] + (size_t)e * DM * 4096; t.WT = a.ws + WS_W1T + (size_t)e * 4096 * DM; t.K = DM; t.N = 4096; t.k0 = 128 * (q / 16); t.n0 = 256 * (q % 16); t.perm = true; }
    else { const int p = r - NEXP * P0_T_E1; const int e = p / P0_T_E2, q = p % P0_T_E2; t.W = a.in[I_W2] + (size_t)e * DEXP * DM; t.WT = a.ws + WS_W2T + (size_t)e * DM * DEXP; t.K = DEXP; t.N = DM; t.k0 = 128 * (q / 8); t.n0 = 256 * (q % 8); t.perm = false; }
    return t;
}
__device__ __forceinline__ void cv_issue(const Frame& F, const Args& a, int it, int qq, int slot) {
    const P0Tile t = p0_tile_decode(a, it);
    LAS unsigned char* dst = F.lds + slot * 32768;
#pragma unroll
    for (int j = 0; j < 4; ++j) { const int kq = F.wave + 8 * j;
        const float* src = t.W + (size_t)(t.k0 + 4 * kq + (F.lane >> 4)) * t.N + t.n0 + 64 * qq + 4 * ((F.lane & 15) ^ (kq >> 2));
        __builtin_amdgcn_global_load_lds((const unsigned*)src, (LAS unsigned*)(dst + kq * 1024), 16, 0, 2); }
}
__device__ __forceinline__ void cv_convert(const Frame& F, const Args& a, int it, int qq, int slot) {
    const P0Tile t = p0_tile_decode(a, it);
    const int kg = F.lane & 7, n = 8 * F.wave + (F.lane >> 3);
    const LAS float* src = (const LAS float*)(F.lds + slot * 32768 + (16 * kg) * 256 + 16 * ((n >> 2) ^ kg) + 4 * (n & 3));
    float f[16];
#pragma unroll
    for (int i = 0; i < 16; ++i) f[i] = src[i * 64] * pg8::W8_SCALE;
    const int nl = 64 * qq + n;
    const int drow = t.n0 + (t.perm ? ((nl & 1) * 128 + (nl >> 1)) : nl);
    v4u o; o.x = pg8::cvt4_fp8(f[0], f[1], f[2], f[3]); o.y = pg8::cvt4_fp8(f[4], f[5], f[6], f[7]); o.z = pg8::cvt4_fp8(f[8], f[9], f[10], f[11]); o.w = pg8::cvt4_fp8(f[12], f[13], f[14], f[15]);
    *(GAS v4u*)(t.WT + (size_t)drow * t.K + t.k0 + 16 * kg) = o;
}
__device__ __forceinline__ void p0_expert_tiles(const Frame& F, const Args& a, int first, int stride, int lo, int hi) {
    const int t0 = lo + first;
    if (t0 >= hi) return;
    const int Q = 4 * ((hi - t0 + stride - 1) / stride);
#define CV_G(g) ((g) < Q ? (g) : Q - 1)
#define CV_TILE(g) (t0 + (CV_G(g) >> 2) * stride)
#define CV_QQ(g) (CV_G(g) & 3)
    cv_issue(F, a, CV_TILE(0), CV_QQ(0), 0); cv_issue(F, a, CV_TILE(1), CV_QQ(1), 1); cv_issue(F, a, CV_TILE(2), CV_QQ(2), 2);
    for (int g = 0; g < Q; ++g) {
        if (g >= 3) asm volatile("s_waitcnt vmcnt(11)" ::: "memory"); else if (g == 2) asm volatile("s_waitcnt vmcnt(10)" ::: "memory");
        else if (g == 1) asm volatile("s_waitcnt vmcnt(9)" ::: "memory"); else asm volatile("s_waitcnt vmcnt(8)" ::: "memory");
        __builtin_amdgcn_s_barrier(); asm volatile("" ::: "memory");
        cv_issue(F, a, CV_TILE(g + 3), CV_QQ(g + 3), (g + 3) & 3);
        cv_convert(F, a, CV_TILE(g), CV_QQ(g), g & 3);
    }
    asm volatile("s_waitcnt vmcnt(0)" ::: "memory"); __builtin_amdgcn_s_barrier(); asm volatile("" ::: "memory");
#undef CV_G
#undef CV_TILE
#undef CV_QQ
}
__device__ __forceinline__ void p0_expert_tiles_blk(const Frame& F, const Args& a, int first, int stride, int lo, int hi) {
    const float* W1 = a.in[I_W1]; const float* W2 = a.in[I_W2]; unsigned char* W1T = a.ws + WS_W1T; unsigned char* W2T = a.ws + WS_W2T;
    LAS float* scr = (LAS float*)F.lds;
    for (int it = lo + first; it < hi; it += stride) {
        int r = it;
        if (r < NEXP * P0_T_E1) { const int e = r / P0_T_E1; p0_block_tile_fp8<true>(W1 + (size_t)e * DM * 4096, DM, 4096, W1T + (size_t)e * 4096 * DM, scr, r % P0_T_E1, F.tid); continue; } r -= NEXP * P0_T_E1;
        { const int e = r / P0_T_E2; p0_block_tile_fp8<false>(W2 + (size_t)e * DEXP * DM, DEXP, DM, W2T + (size_t)e * DM * DEXP, scr, r % P0_T_E2, F.tid); }
    }
}
__device__ __forceinline__ void p0_prologue(const Frame& F, const Args& a) {
    const float* Win = a.in[I_WIN]; const float* Wout = a.in[I_WOUT]; const float* W1 = a.in[I_W1]; const float* W2 = a.in[I_W2];
    bf16* WinT = (bf16*)(a.ws + WS_WIN_T); bf16* WoutT = (bf16*)(a.ws + WS_WOUT_T); unsigned char* W1T = a.ws + WS_W1T; unsigned char* W2T = a.ws + WS_W2T;
    p0_expert_tiles_blk(F, a, blockIdx.x, F.G, 0, F.G == 256 ? P0_PRE_TILES : P0_NTILES - P0_LATE_TILES);
    { LAS float* scr = (LAS float*)(F.lds + F.wave * 16384);
      constexpr int I_IN = (DM / 64) * (INC / 32), I_OUT = (DM / 64) * (DM / 32);
      for (int it = F.gw; it < I_IN + I_OUT; it += F.NGW) {
          if (it < I_IN) p0_transpose_item(Win, DM, INC, WinT, scr, it, F.lane); else p0_transpose_item(Wout, DM, DM, WoutT, scr, it - I_IN, F.lane);
      } }
    { float* WRT = (float*)(a.ws + WS_WRT); const float* Wr = a.in[I_WR];
      for (int i = blockIdx.x * NTHREADS + F.tid; i < DM * NEXP; i += F.G * NTHREADS) { const int e = i / DM, d = i % DM; WRT[i] = Wr[(size_t)d * NEXP + e]; } }
    bf16* H = (bf16*)(a.ws + WS_H);
    for (int m = F.gw; m < NTOK; m += F.NGW) rms_row_to_bf16(a.in[I_X] + (size_t)m * DM, a.in[I_MIXN], H + (size_t)m * DM, F.lane);
}

typedef short s16x8 __attribute__((ext_vector_type(8)));
constexpr int VT_STRIDE = 272;
constexpr int VT_BYTES = 128 * VT_STRIDE;
__device__ __forceinline__ void gmlp_stage_vt(const Frame& F, const Args& a, int row0, int h, LAS unsigned char* VT, const LAS float* st) {
    const bf16* Z = (const bf16*)(a.ws + WS_Z);
    const int dg = F.tid >> 5, sg = F.tid & 31;
    const float* lw = a.in[I_LNW] + h * 128 + 8 * dg; const float* lb = a.in[I_LNB] + h * 128 + 8 * dg;
    float w8[8], b8[8];
#pragma unroll
    for (int j = 0; j < 8; ++j) { w8[j] = lw[j]; b8[j] = lb[j]; }
    float x[4][8];
#pragma unroll
    for (int i = 0; i < 4; ++i) { const int s = 4 * sg + i; const v4u q = *(const GAS v4u*)(Z + (size_t)(row0 + s) * INC + ZV + h * 128 + 8 * dg); const float mu = st[s], rs = st[128 + s];
        const unsigned w[4] = {q.x, q.y, q.z, q.w};
#pragma unroll
        for (int j = 0; j < 4; ++j) { x[i][2 * j] = (bflo(w[j]) - mu) * rs * w8[2 * j] + b8[2 * j]; x[i][2 * j + 1] = (bfhi(w[j]) - mu) * rs * w8[2 * j + 1] + b8[2 * j + 1]; } }
#pragma unroll
    for (int j = 0; j < 8; ++j) { v2u o; o.x = pk2(x[0][j], x[1][j]); o.y = pk2(x[2][j], x[3][j]); *(LAS v2u*)(VT + (8 * dg + j) * VT_STRIDE + 8 * sg) = o; }
}
__device__ __forceinline__ void gmlp_item_mfma(const Frame& F, const Args& a, int item) {
    const bf16* Z = (const bf16*)(a.ws + WS_Z); bf16* CAT = (bf16*)(a.ws + WS_CAT); float* SSQ = (float*)(a.ws + WS_ARAW);
    LAS unsigned char* VT0 = F.lds + RING_OFF;
    LAS float* st = (LAS float*)(F.lds + SMALL_OFF);
    const int hh = item & 1, row0 = (item >> 1) * 128, fr = F.lane & 15, fq = F.lane >> 4;
#pragma unroll 1
    for (int rb = 0; rb < 4; ++rb) { v4u q[4][2];
#pragma unroll
        for (int r = 0; r < 4; ++r) { const GAS v4u* vp = (const GAS v4u*)(Z + (size_t)(row0 + 16 * F.wave + 4 * rb + r) * INC + ZV + 16 * F.lane); q[r][0] = vp[0]; q[r][1] = vp[1]; }
#pragma unroll
        for (int r = 0; r < 4; ++r) { float x[16]; unpack16(q[r][0], q[r][1], x); float sm = 0.f;
#pragma unroll
            for (int i = 0; i < 16; ++i) sm += x[i];
            const float mu = wave_sum(sm) * (1.f / DA); float qq = 0.f;
#pragma unroll
            for (int i = 0; i < 16; ++i) { const float d = x[i] - mu; qq += d * d; }
            const float rstd = 1.0f / sqrtf(wave_sum(qq) * (1.f / DA) + EPS);
            if (F.lane == 0) { st[16 * F.wave + 4 * rb + r] = mu; st[128 + 16 * F.wave + 4 * rb + r] = rstd; } } }
    __syncthreads();
    gmlp_stage_vt(F, a, row0, 4 * hh, VT0, st);
    LBAR();
    const int t = 16 * F.wave + fr;
    float ssq = 0.f;
    for (int hi = 0; hi < 4; ++hi) { const int h = 4 * hh + hi;
        LAS unsigned char* VT = VT0 + (hi & 1) * VT_BYTES;
        s16x8 af[4];
        { const GAS f32x4* wp = (const GAS f32x4*)(a.in[I_WSP] + (size_t)h * 16384 + (size_t)t * 128 + 8 * fq);
#pragma unroll
          for (int ks = 0; ks < 4; ++ks) { const f32x4 p = wp[8 * ks], q = wp[8 * ks + 1];
              const v4u pk = {pk2(p.x, p.y), pk2(p.z, p.w), pk2(q.x, q.y), pk2(q.z, q.w)}; af[ks] = __builtin_bit_cast(s16x8, pk); } }
        v2u uq[8];
#pragma unroll
        for (int nt = 0; nt < 8; ++nt) uq[nt] = *(const GAS v2u*)(Z + (size_t)(row0 + t) * INC + ZU + h * 128 + 16 * nt + 4 * fq);
        const float bsv = a.in[I_BSP][h * 128 + t];
        if (hi + 1 < 4) gmlp_stage_vt(F, a, row0, h + 1, VT0 + ((hi + 1) & 1) * VT_BYTES, st);
        f32x4 acc[8];
#pragma unroll
        for (int nt = 0; nt < 8; ++nt) acc[nt] = (f32x4){0.f, 0.f, 0.f, 0.f};
#pragma unroll
        for (int ks = 0; ks < 4; ++ks)
#pragma unroll
            for (int nt = 0; nt < 8; ++nt) { const s16x8 bfr = *(const LAS s16x8*)(VT + (16 * nt + fr) * VT_STRIDE + (32 * ks + 8 * fq) * 2);
                acc[nt] = __builtin_amdgcn_mfma_f32_16x16x32_bf16(bfr, af[ks], acc[nt], 0, 0, 0); }
#pragma unroll
        for (int nt = 0; nt < 8; ++nt) { const int d0 = 16 * nt + 4 * fq;
            const float a0 = bflo(uq[nt].x) * (acc[nt][0] + bsv), a1 = bfhi(uq[nt].x) * (acc[nt][1] + bsv), a2 = bflo(uq[nt].y) * (acc[nt][2] + bsv), a3 = bfhi(uq[nt].y) * (acc[nt][3] + bsv);
            ssq += (a0 * a0 + a1 * a1) + (a2 * a2 + a3 * a3);
            v2u o; o.x = pk2(a0, a1); o.y = pk2(a2, a3); *(GAS v2u*)(CAT + (size_t)(row0 + t) * DM + h * 128 + d0) = o; }
        LBAR();
    }
    ssq += __shfl_xor(ssq, 16); ssq += __shfl_xor(ssq, 32);
    if (fq == 0) SSQ[(size_t)hh * NTOK + row0 + t] = ssq;
}

constexpr int HG_SS = 144;
constexpr int HG_QD = 0, HG_KD = 9216, HG_KT = 18432, HG_IT = 27648, HG_SC = 46080, HG_DEC = 55296, HG_GS = 55552, HG_PAR = 57600;
constexpr int HG_ST0 = 2 * HG_PAR, HG_ST1 = HG_ST0 + 18432, HG_END = HG_ST1 + 18432;
static_assert(HG_END <= MISC_OFF, "hgrn LDS map");
__device__ __forceinline__ void hgrn_item_mfma(const Frame& F, const Args& a, int item) {
    const char* Zb = (const char*)(a.ws + WS_Z);
    const int b = item >> 5, h = (item >> 2) & 7, dir = (item >> 1) & 1, kh = item & 1;
    char* Ob = (char*)(a.ws + (dir ? WS_OB : WS_OF)) + (size_t)kh * NTOK * DA * 2;
    LAS unsigned char* L = F.lds;
    const int fr = F.lane & 15, fq = F.lane >> 4, w = F.wave, lane = F.lane;
    const int kp = lane & 31, hf = lane >> 5, tg = 2 * w + hf;
    const float* tab = dir ? a.in[I_LBB] : a.in[I_LBF];
    float lb0, lb1;
    { const int kc = h * 128 + 64 * kh + 2 * kp; const float t0 = tab[kc], t1 = tab[1024 + kc]; lb0 = 1.0f / (1.0f + expf(t1 - t0));
      const float u0 = tab[kc + 1], u1 = tab[1024 + kc + 1]; lb1 = 1.0f / (1.0f + expf(u1 - u0)); }
    const float om0 = 1.0f - lb0, om1 = 1.0f - lb1;
    unsigned offz[4], offi[8];
#pragma unroll
    for (int i = 0; i < 4; ++i) { const int j = 4 * tg + i, jr = dir ? 63 - j : j; offz[i] = (unsigned)(jr * INC + h * 128 + 64 * kh + 2 * kp) * 2u; }
#pragma unroll
    for (int i = 0; i < 8; ++i) { const int j = 8 * w + i, jr = dir ? 63 - j : j; offi[i] = (unsigned)(jr * INC + h * 128 + ZI + 2 * lane) * 2u; }
    const unsigned zfo = (unsigned)(dir ? ZFB : ZFF) * 2u, zqo = (unsigned)ZQ * 2u;
    unsigned offo; { const int j = 16 * (w >> 1) + fr, jr = dir ? 63 - j : j; offo = (unsigned)(jr * DA + h * 128 + 64 * (w & 1) + 4 * fq) * 2u; }
    for (int i = F.tid; i < 18432 / 4; i += NTHREADS) ((LAS unsigned*)(L + HG_ST0))[i] = 0u;
    f32x4 S[4];
#pragma unroll
    for (int vj = 0; vj < 4; ++vj) S[vj] = (f32x4){0.f, 0.f, 0.f, 0.f};
    unsigned zq[4], qq[4], iq[8];
    float cum0[4], cum1[4], kk0[4], kk1[4], o0 = 0.f, o1 = 0.f;
#define HG_BLOCK(n) ((size_t)(b * SEQ + (dir ? (SEQ - 64 - (n) * 64) : ((n) * 64))))
#define HG_LOAD_ZI(n) do { const char* zc = Zb + HG_BLOCK(n) * (size_t)(INC * 2); \
        _Pragma("unroll") for (int i = 0; i < 4; ++i) zq[i] = *(const GAS unsigned*)(zc + zfo + offz[i]); \
        _Pragma("unroll") for (int i = 0; i < 8; ++i) iq[i] = *(const GAS unsigned*)(zc + offi[i]); } while (0)
#define HG_LOAD_Q(n) do { const char* zc = Zb + HG_BLOCK(n) * (size_t)(INC * 2); \
        _Pragma("unroll") for (int i = 0; i < 4; ++i) qq[i] = *(const GAS unsigned*)(zc + zqo + offz[i]); } while (0)
#define HG_A1(c) do { LAS unsigned char* P = L + ((c) & 1) * HG_PAR; float c0 = 0.f, c1 = 0.f; \
        _Pragma("unroll") for (int i = 0; i < 4; ++i) { const float z0 = bflo(zq[i]), z1 = bfhi(zq[i]); \
            const float s0 = __builtin_amdgcn_rcpf(1.0f + __builtin_amdgcn_exp2f(-1.44269504089f * z0)), s1 = __builtin_amdgcn_rcpf(1.0f + __builtin_amdgcn_exp2f(-1.44269504089f * z1)); \
            const float f0 = lb0 + om0 * s0, f1 = lb1 + om1 * s1; \
            kk0[i] = om0 - om0 * s0; kk1[i] = om1 - om1 * s1; \
            c0 += __builtin_amdgcn_logf(f0); c1 += __builtin_amdgcn_logf(f1); cum0[i] = c0; cum1[i] = c1; } \
        o0 = __shfl_xor(c0, 32); o1 = __shfl_xor(c1, 32); \
        if (hf == 0) *(LAS f32x2t*)(P + HG_GS + (w * 64 + 2 * kp) * 4) = (f32x2t){c0 + o0, c1 + o1}; \
        { v4u q0, q1; \
          q0.x = (iq[0] & 0xffffu) | (iq[1] << 16); q0.y = (iq[2] & 0xffffu) | (iq[3] << 16); q0.z = (iq[4] & 0xffffu) | (iq[5] << 16); q0.w = (iq[6] & 0xffffu) | (iq[7] << 16); \
          q1.x = (iq[0] >> 16) | (iq[1] & 0xffff0000u); q1.y = (iq[2] >> 16) | (iq[3] & 0xffff0000u); q1.z = (iq[4] >> 16) | (iq[5] & 0xffff0000u); q1.w = (iq[6] >> 16) | (iq[7] & 0xffff0000u); \
          *(LAS v4u*)(P + HG_IT + (2 * lane) * HG_SS + 16 * w) = q0; *(LAS v4u*)(P + HG_IT + (2 * lane + 1) * HG_SS + 16 * w) = q1; } } while (0)
#define HG_A2(c) do { LAS unsigned char* P = L + ((c) & 1) * HG_PAR; float off0 = hf ? o0 : 0.f, off1 = hf ? o1 : 0.f, tot0 = 0.f, tot1 = 0.f; \
        _Pragma("unroll") for (int g = 0; g < 8; ++g) { const f32x2t gs = *(const LAS f32x2t*)(P + HG_GS + (g * 64 + 2 * kp) * 4); if (g < w) { off0 += gs.x; off1 += gs.y; } tot0 += gs.x; tot1 += gs.y; } \
        const float dec0 = __builtin_amdgcn_exp2f(tot0), dec1 = __builtin_amdgcn_exp2f(tot1); \
        if (tg == 0) *(LAS f32x2t*)(P + HG_DEC + 8 * kp) = (f32x2t){dec0, dec1}; \
        float kt0[4], kt1[4]; \
        _Pragma("unroll") for (int i = 0; i < 4; ++i) { const float e0 = __builtin_amdgcn_exp2f(cum0[i] + off0), e1 = __builtin_amdgcn_exp2f(cum1[i] + off1); \
            const float kd0 = kk0[i] * __builtin_amdgcn_rcpf(e0), kd1 = kk1[i] * __builtin_amdgcn_rcpf(e1); \
            *(LAS unsigned*)(P + HG_QD + (4 * tg + i) * HG_SS + 4 * kp) = pk2(bflo(qq[i]) * e0, bfhi(qq[i]) * e1); \
            *(LAS unsigned*)(P + HG_KD + (4 * tg + i) * HG_SS + 4 * kp) = pk2(kd0, kd1); \
            kt0[i] = kd0 * dec0; kt1[i] = kd1 * dec1; } \
        *(LAS v2u*)(P + HG_KT + (2 * kp) * HG_SS + 8 * tg) = (v2u){pk2(kt0[0], kt0[1]), pk2(kt0[2], kt0[3])}; \
        *(LAS v2u*)(P + HG_KT + (2 * kp + 1) * HG_SS + 8 * tg) = (v2u){pk2(kt1[0], kt1[1]), pk2(kt1[2], kt1[3])}; } while (0)
    HG_LOAD_ZI(0); HG_LOAD_Q(0);
    LBAR();
    HG_A1(0);
    HG_LOAD_ZI(1);
    LBAR();
    HG_A2(0);
    HG_LOAD_Q(1);
    LBAR();
    for (int n = 0; n < SEQ / 64; ++n) {
        LAS unsigned char* P = L + (n & 1) * HG_PAR;
        LAS unsigned char* STc = L + ((n & 1) ? HG_ST1 : HG_ST0); LAS unsigned char* STn = L + ((n & 1) ? HG_ST0 : HG_ST1);
        { const int ti = w >> 1;
#pragma unroll
          for (int sj = 0; sj < 2; ++sj) { const int si = 2 * (w & 1) + sj; f32x4 acc = (f32x4){0.f, 0.f, 0.f, 0.f};
              if (si <= ti) {
#pragma unroll
                  for (int ks = 0; ks < 2; ++ks) { const s16x8 kf = *(const LAS s16x8*)(P + HG_KD + (16 * si + fr) * HG_SS + (32 * ks + 8 * fq) * 2), qf = *(const LAS s16x8*)(P + HG_QD + (16 * ti + fr) * HG_SS + (32 * ks + 8 * fq) * 2);
                      acc = __builtin_amdgcn_mfma_f32_16x16x32_bf16(kf, qf, acc, 0, 0, 0); } }
              const int t = 16 * ti + fr, s0 = 16 * si + 4 * fq;
              v2u o; o.x = pk2(s0 <= t ? acc[0] : 0.f, s0 + 1 <= t ? acc[1] : 0.f); o.y = pk2(s0 + 2 <= t ? acc[2] : 0.f, s0 + 3 <= t ? acc[3] : 0.f);
              *(LAS v2u*)(P + HG_SC + t * HG_SS + s0 * 2) = o; } }
        if (n + 1 < SEQ / 64) { HG_A1(n + 1); if (n + 2 < SEQ / 64) HG_LOAD_ZI(n + 2); }
        LBAR();
        if (n + 1 < SEQ / 64) { HG_A2(n + 1); if (n + 2 < SEQ / 64) HG_LOAD_Q(n + 2); }
        { const int ti = w >> 1;
          char* oc = Ob + HG_BLOCK(n) * (size_t)(DA * 2) + offo;
          s16x8 scf[2], qf[2];
#pragma unroll
          for (int ks = 0; ks < 2; ++ks) { scf[ks] = *(const LAS s16x8*)(P + HG_SC + (16 * ti + fr) * HG_SS + (32 * ks + 8 * fq) * 2); qf[ks] = *(const LAS s16x8*)(P + HG_QD + (16 * ti + fr) * HG_SS + (32 * ks + 8 * fq) * 2); }
#pragma unroll
          for (int vj = 0; vj < 4; ++vj) { const int vi = 4 * (w & 1) + vj; f32x4 acc = (f32x4){0.f, 0.f, 0.f, 0.f};
#pragma unroll
              for (int ks = 0; ks < 2; ++ks) { const s16x8 itf = *(const LAS s16x8*)(P + HG_IT + (16 * vi + fr) * HG_SS + (32 * ks + 8 * fq) * 2);
                  acc = __builtin_amdgcn_mfma_f32_16x16x32_bf16(itf, scf[ks], acc, 0, 0, 0); }
#pragma unroll
              for (int ks = 0; ks < 2; ++ks) { const s16x8 stf = *(const LAS s16x8*)(STc + (16 * vi + fr) * HG_SS + (32 * ks + 8 * fq) * 2);
                  acc = __builtin_amdgcn_mfma_f32_16x16x32_bf16(stf, qf[ks], acc, 0, 0, 0); }
              v2u o; o.x = pk2(acc[0], acc[1]); o.y = pk2(acc[2], acc[3]);
              *(GAS v2u*)(oc + 32 * vj) = o; } }
        { const int kt = w & 3;
          const f32x4 dc = *(const LAS f32x4*)(P + HG_DEC + (16 * kt + 4 * fq) * 4);
          s16x8 ktf[2];
#pragma unroll
          for (int ks = 0; ks < 2; ++ks) ktf[ks] = *(const LAS s16x8*)(P + HG_KT + (16 * kt + fr) * HG_SS + (32 * ks + 8 * fq) * 2);
#pragma unroll
          for (int vj = 0; vj < 4; ++vj) { const int vi = 4 * (w >> 2) + vj; S[vj] = S[vj] * dc;
#pragma unroll
              for (int ks = 0; ks < 2; ++ks) { const s16x8 itf = *(const LAS s16x8*)(P + HG_IT + (16 * vi + fr) * HG_SS + (32 * ks + 8 * fq) * 2);
                  S[vj] = __builtin_amdgcn_mfma_f32_16x16x32_bf16(ktf[ks], itf, S[vj], 0, 0, 0); }
              v2u o; o.x = pk2(S[vj][0], S[vj][1]); o.y = pk2(S[vj][2], S[vj][3]);
              *(LAS v2u*)(STn + (16 * vi + fr) * HG_SS + (16 * kt + 4 * fq) * 2) = o; } }
        LBAR();
    }
#undef HG_BLOCK
#undef HG_LOAD_ZI
#undef HG_LOAD_Q
#undef HG_A1
#undef HG_A2
}

constexpr int HF_QS = 272, HF_SS = 144;
constexpr int HF_QD = 0, HF_KD = 17408, HF_KT = 34816, HF_IT = 53248, HF_SC = 71680, HF_ST0 = 80896, HF_ST1 = 115712, HF_GS = 150528, HF_DEC = 154624, HF_END = 155136;
static_assert(HF_END <= MISC_OFF, "hgrn (full k) LDS map");
__device__ __forceinline__ void hgrn_full_item(const Frame& F, const Args& a, int item) {
    const char* Zb = (const char*)(a.ws + WS_Z);
    const int b = item >> 4, h = (item >> 1) & 7, dir = item & 1;
    char* Ob = (char*)(a.ws + (dir ? WS_OB : WS_OF));
    LAS unsigned char* L = F.lds;
    const int fr = F.lane & 15, fq = F.lane >> 4, w = F.wave, lane = F.lane;
    const float* tab = dir ? a.in[I_LBB] : a.in[I_LBF];
    float lb0, lb1;
    { const int kc = h * 128 + 2 * lane; const float t0 = tab[kc], t1 = tab[1024 + kc]; lb0 = 1.0f / (1.0f + expf(t1 - t0));
      const float u0 = tab[kc + 1], u1 = tab[1024 + kc + 1]; lb1 = 1.0f / (1.0f + expf(u1 - u0)); }
    const float om0 = 1.0f - lb0, om1 = 1.0f - lb1;
    unsigned offr[8];
#pragma unroll
    for (int i = 0; i < 8; ++i) { const int j = 8 * w + i, jr = dir ? 63 - j : j; offr[i] = (unsigned)(jr * INC + h * 128 + 2 * lane) * 2u; }
    const unsigned zfo = (unsigned)(dir ? ZFB : ZFF) * 2u, zqo = (unsigned)ZQ * 2u, zio = (unsigned)ZI * 2u;
    unsigned offo; { const int j = 16 * (w >> 1) + fr, jr = dir ? 63 - j : j; offo = (unsigned)(jr * DA + h * 128 + 64 * (w & 1) + 4 * fq) * 2u; }
    for (int i = F.tid; i < 34816 / 4; i += NTHREADS) ((LAS unsigned*)(L + HF_ST0))[i] = 0u;
    f32x4 S[8];
#pragma unroll
    for (int vi = 0; vi < 8; ++vi) S[vi] = (f32x4){0.f, 0.f, 0.f, 0.f};
    unsigned zq[8], qq[8], iq[8];
#define HF_BLOCK(n) ((size_t)(b * SEQ + (dir ? (SEQ - 64 - (n) * 64) : ((n) * 64))))
#define HF_LOAD(n) do { const char* zc = Zb + HF_BLOCK(n) * (size_t)(INC * 2); \
        _Pragma("unroll") for (int i = 0; i < 8; ++i) { zq[i] = *(const GAS unsigned*)(zc + zfo + offr[i]); qq[i] = *(const GAS unsigned*)(zc + zqo + offr[i]); iq[i] = *(const GAS unsigned*)(zc + zio + offr[i]); } } while (0)
    HF_LOAD(0);
    LBAR();
    for (int n = 0; n < SEQ / 64; ++n) {
        LAS unsigned char* STc = L + ((n & 1) ? HF_ST1 : HF_ST0); LAS unsigned char* STn = L + ((n & 1) ? HF_ST0 : HF_ST1);
        float cum0[8], cum1[8], kk0[8], kk1[8]; float c0 = 0.f, c1 = 0.f;
#pragma unroll
        for (int i = 0; i < 8; ++i) { const float z0 = bflo(zq[i]), z1 = bfhi(zq[i]);
            const float s0 = __builtin_amdgcn_rcpf(1.0f + __builtin_amdgcn_exp2f(-1.44269504089f * z0)), s1 = __builtin_amdgcn_rcpf(1.0f + __builtin_amdgcn_exp2f(-1.44269504089f * z1));
            const float f0 = lb0 + om0 * s0, f1 = lb1 + om1 * s1;
            kk0[i] = om0 - om0 * s0; kk1[i] = om1 - om1 * s1;
            c0 += __builtin_amdgcn_logf(f0); c1 += __builtin_amdgcn_logf(f1); cum0[i] = c0; cum1[i] = c1; }
        *(LAS f32x2t*)(L + HF_GS + (w * 128 + 2 * lane) * 4) = (f32x2t){c0, c1};
        { v4u q0, q1;
          q0.x = (iq[0] & 0xffffu) | (iq[1] << 16); q0.y = (iq[2] & 0xffffu) | (iq[3] << 16); q0.z = (iq[4] & 0xffffu) | (iq[5] << 16); q0.w = (iq[6] & 0xffffu) | (iq[7] << 16);
          q1.x = (iq[0] >> 16) | (iq[1] & 0xffff0000u); q1.y = (iq[2] >> 16) | (iq[3] & 0xffff0000u); q1.z = (iq[4] >> 16) | (iq[5] & 0xffff0000u); q1.w = (iq[6] >> 16) | (iq[7] & 0xffff0000u);
          *(LAS v4u*)(L + HF_IT + (2 * lane) * HF_SS + 16 * w) = q0; *(LAS v4u*)(L + HF_IT + (2 * lane + 1) * HF_SS + 16 * w) = q1; }
        LBAR();
        { float off0 = 0.f, off1 = 0.f, tot0 = 0.f, tot1 = 0.f;
#pragma unroll
          for (int g = 0; g < 8; ++g) { const f32x2t gs = *(const LAS f32x2t*)(L + HF_GS + (g * 128 + 2 * lane) * 4); if (g < w) { off0 += gs.x; off1 += gs.y; } tot0 += gs.x; tot1 += gs.y; }
          const float dec0 = __builtin_amdgcn_exp2f(tot0), dec1 = __builtin_amdgcn_exp2f(tot1);
          if (w == 0) *(LAS f32x2t*)(L + HF_DEC + 8 * lane) = (f32x2t){dec0, dec1};
          float kt0[8], kt1[8];
#pragma unroll
          for (int i = 0; i < 8; ++i) { const float e0 = __builtin_amdgcn_exp2f(cum0[i] + off0), e1 = __builtin_amdgcn_exp2f(cum1[i] + off1);
              const float kd0 = kk0[i] * __builtin_amdgcn_rcpf(e0), kd1 = kk1[i] * __builtin_amdgcn_rcpf(e1);
              *(LAS unsigned*)(L + HF_QD + (8 * w + i) * HF_QS + 4 * lane) = pk2(bflo(qq[i]) * e0, bfhi(qq[i]) * e1);
              *(LAS unsigned*)(L + HF_KD + (8 * w + i) * HF_QS + 4 * lane) = pk2(kd0, kd1);
              kt0[i] = kd0 * dec0; kt1[i] = kd1 * dec1; }
          *(LAS v4u*)(L + HF_KT + (2 * lane) * HF_SS + 16 * w) = (v4u){pk2(kt0[0], kt0[1]), pk2(kt0[2], kt0[3]), pk2(kt0[4], kt0[5]), pk2(kt0[6], kt0[7])};
          *(LAS v4u*)(L + HF_KT + (2 * lane + 1) * HF_SS + 16 * w) = (v4u){pk2(kt1[0], kt1[1]), pk2(kt1[2], kt1[3]), pk2(kt1[4], kt1[5]), pk2(kt1[6], kt1[7])}; }
        if (n + 1 < SEQ / 64) HF_LOAD(n + 1);
        LBAR();
        { const int ti = w >> 1;
#pragma unroll
          for (int sj = 0; sj < 2; ++sj) { const int si = 2 * (w & 1) + sj; f32x4 acc = (f32x4){0.f, 0.f, 0.f, 0.f};
              if (si <= ti) {
#pragma unroll
                  for (int ks = 0; ks < 4; ++ks) { const s16x8 kf = *(const LAS s16x8*)(L + HF_KD + (16 * si + fr) * HF_QS + (32 * ks + 8 * fq) * 2), qf = *(const LAS s16x8*)(L + HF_QD + (16 * ti + fr) * HF_QS + (32 * ks + 8 * fq) * 2);
                      acc = __builtin_amdgcn_mfma_f32_16x16x32_bf16(kf, qf, acc, 0, 0, 0); } }
              const int t = 16 * ti + fr, s0 = 16 * si + 4 * fq;
              v2u o; o.x = pk2(s0 <= t ? acc[0] : 0.f, s0 + 1 <= t ? acc[1] : 0.f); o.y = pk2(s0 + 2 <= t ? acc[2] : 0.f, s0 + 3 <= t ? acc[3] : 0.f);
              *(LAS v2u*)(L + HF_SC + t * HF_SS + s0 * 2) = o; } }
        LBAR();
        { const int ti = w >> 1;
          char* oc = Ob + HF_BLOCK(n) * (size_t)(DA * 2) + offo;
          s16x8 scf[2], qf[4];
#pragma unroll
          for (int ks = 0; ks < 2; ++ks) scf[ks] = *(const LAS s16x8*)(L + HF_SC + (16 * ti + fr) * HF_SS + (32 * ks + 8 * fq) * 2);
#pragma unroll
          for (int ks = 0; ks < 4; ++ks) qf[ks] = *(const LAS s16x8*)(L + HF_QD + (16 * ti + fr) * HF_QS + (32 * ks + 8 * fq) * 2);
#pragma unroll
          for (int vj = 0; vj < 4; ++vj) { const int vi = 4 * (w & 1) + vj; f32x4 acc = (f32x4){0.f, 0.f, 0.f, 0.f};
#pragma unroll
              for (int ks = 0; ks < 2; ++ks) { const s16x8 itf = *(const LAS s16x8*)(L + HF_IT + (16 * vi + fr) * HF_SS + (32 * ks + 8 * fq) * 2);
                  acc = __builtin_amdgcn_mfma_f32_16x16x32_bf16(itf, scf[ks], acc, 0, 0, 0); }
#pragma unroll
              for (int ks = 0; ks < 4; ++ks) { const s16x8 stf = *(const LAS s16x8*)(STc + (16 * vi + fr) * HF_QS + (32 * ks + 8 * fq) * 2);
                  acc = __builtin_amdgcn_mfma_f32_16x16x32_bf16(stf, qf[ks], acc, 0, 0, 0); }
              v2u o; o.x = pk2(acc[0], acc[1]); o.y = pk2(acc[2], acc[3]);
              *(GAS v2u*)(oc + 32 * vj) = o; } }
        { const f32x4 dc = *(const LAS f32x4*)(L + HF_DEC + (16 * w + 4 * fq) * 4);
          s16x8 ktf[2];
#pragma unroll
          for (int ks = 0; ks < 2; ++ks) ktf[ks] = *(const LAS s16x8*)(L + HF_KT + (16 * w + fr) * HF_SS + (32 * ks + 8 * fq) * 2);
#pragma unroll
          for (int vi = 0; vi < 8; ++vi) { S[vi] = S[vi] * dc;
#pragma unroll
              for (int ks = 0; ks < 2; ++ks) { const s16x8 itf = *(const LAS s16x8*)(L + HF_IT + (16 * vi + fr) * HF_SS + (32 * ks + 8 * fq) * 2);
                  S[vi] = __builtin_amdgcn_mfma_f32_16x16x32_bf16(ktf[ks], itf, S[vi], 0, 0, 0); }
              v2u o; o.x = pk2(S[vi][0], S[vi][1]); o.y = pk2(S[vi][2], S[vi][3]);
              *(LAS v2u*)(STn + (16 * vi + fr) * HF_QS + (16 * w + 4 * fq) * 2) = o; } }
        LBAR();
    }
#undef HF_BLOCK
#undef HF_LOAD
}

__device__ __forceinline__ void gmlp_full_item(const Frame& F, const Args& a, int item) {
    gmlp_item_mfma(F, a, 2 * item);
    __syncthreads();
    gmlp_item_mfma(F, a, 2 * item + 1);
    VM_WAIT();
    __syncthreads();
    bf16* CAT = (bf16*)(a.ws + WS_CAT); const float* SSQ = (const float*)(a.ws + WS_ARAW);
    LAS float* rs = (LAS float*)(F.lds + SMALL_OFF) + 256;
    const int row0 = item * 128;
    if (F.tid < 128) rs[F.tid] = 1.0f / sqrtf((SSQ[row0 + F.tid] + SSQ[NTOK + row0 + F.tid]) * (1.f / DA) + EPS);
    __syncthreads();
    { const int cg = F.tid & 127, rg = F.tid >> 7;
      const float* gp = a.in[I_GON] + 8 * cg; float g8[8];
#pragma unroll
      for (int j = 0; j < 8; ++j) g8[j] = gp[j];
#pragma unroll 8
      for (int i = 0; i < 32; ++i) { const int r = rg + 4 * i; const float sc = rs[r];
          GAS v4u* p = (GAS v4u*)(CAT + (size_t)(row0 + r) * DM + 8 * cg); const v4u q = *p;
          v4u o; o.x = pk2(bflo(q.x) * sc * g8[0], bfhi(q.x) * sc * g8[1]); o.y = pk2(bflo(q.y) * sc * g8[2], bfhi(q.y) * sc * g8[3]);
          o.z = pk2(bflo(q.z) * sc * g8[4], bfhi(q.z) * sc * g8[5]); o.w = pk2(bflo(q.w) * sc * g8[6], bfhi(q.w) * sc * g8[7]);
          *p = o; } }
    __syncthreads();
}

__device__ __forceinline__ void p3_cat(const Frame& F, const Args& a) {
    const bf16* Z = (const bf16*)(a.ws + WS_Z);
    const bf16* OF = (const bf16*)(a.ws + WS_OF); const bf16* OB = (const bf16*)(a.ws + WS_OB); bf16* CAT = (bf16*)(a.ws + WS_CAT);
    const float* hon = a.in[I_HON] + (F.lane & 7) * 16;
    float hn[16];
#pragma unroll
    for (int i = 0; i < 16; ++i) hn[i] = hon[i];
    for (int m = F.gw; m < NTOK; m += F.NGW) {
        float x[16], g[16], p0[16], p1[16];
        { const GAS v4u* gp = (const GAS v4u*)(Z + (size_t)m * INC + ZG + 16 * F.lane); const GAS v4u* fp = (const GAS v4u*)(OF + (size_t)m * DA + 16 * F.lane); const GAS v4u* bp = (const GAS v4u*)(OB + (size_t)m * DA + 16 * F.lane);
          const v4u g0 = gp[0], g1 = gp[1], f0 = fp[0], f1 = fp[1], b0 = bp[0], b1 = bp[1];
          unpack16(g0, g1, g); unpack16(f0, f1, p0); unpack16(b0, b1, p1); }
        float ss = 0.f;
#pragma unroll
        for (int i = 0; i < 16; ++i) { x[i] = p0[i] + p1[i]; ss += x[i] * x[i]; }
        ss += __shfl_xor(ss, 1); ss += __shfl_xor(ss, 2); ss += __shfl_xor(ss, 4);
        const float rh = 1.0f / sqrtf(ss * (1.f / 128.f) + EPS);
#pragma unroll
        for (int i = 0; i < 16; ++i) x[i] = x[i] * rh * hn[i] * g[i];
        v4u o0, o1;
        o0.x = pk2(x[0], x[1]); o0.y = pk2(x[2], x[3]); o0.z = pk2(x[4], x[5]); o0.w = pk2(x[6], x[7]);
        o1.x = pk2(x[8], x[9]); o1.y = pk2(x[10], x[11]); o1.z = pk2(x[12], x[13]); o1.w = pk2(x[14], x[15]);
        GAS v4u* cp = (GAS v4u*)(CAT + (size_t)m * DM + DA + 16 * F.lane); cp[0] = o0; cp[1] = o1;
    }
}

__device__ __forceinline__ float rt_dot16(const f32x4 (&x)[4], const f32x4 (&w)[4]) {
    f32x2t s = (f32x2t){x[0].x, x[0].y} * (f32x2t){w[0].x, w[0].y};
    s += (f32x2t){x[0].z, x[0].w} * (f32x2t){w[0].z, w[0].w};
#pragma unroll
    for (int j = 1; j < 4; ++j) { s += (f32x2t){x[j].x, x[j].y} * (f32x2t){w[j].x, w[j].y}; s += (f32x2t){x[j].z, x[j].w} * (f32x2t){w[j].z, w[j].w}; }
    return s.x + s.y;
}
__device__ __forceinline__ void p5_route(const Frame& F, const Args& a) {
    const float* X = a.in[I_X]; const bf16* DL = (const bf16*)(a.ws + WS_X1); unsigned char* H2 = a.ws + WS_H; const float* WRT = (const float*)(a.ws + WS_WRT);
    bf16* X1B = (bf16*)(a.ws + WS_OF);
    unsigned* ctl = (unsigned*)(a.ws + WS_CTL);
    int* tok_e = (int*)(a.ws + WS_ROUTE + RT_TOKE); int* tok_pos = (int*)(a.ws + WS_ROUTE + RT_TOKPOS);
    int* list = (int*)(a.ws + WS_ROUTE + RT_LIST); float* listg = (float*)(a.ws + WS_ROUTE + RT_LISTG);
    LAS float* WL = (LAS float*)(F.lds + RING_OFF);
    LAS int* hist = (LAS int*)(F.lds + SMALL_OFF);
    LAS int* base = hist + 32;
    LAS int* asg_e = hist + 64;
    LAS int* asg_rank = hist + 64 + 256;
    LAS float* asg_gate = (LAS float*)(hist + 64 + 512);
    LAS float* lg = (LAS float*)(hist + 64 + 768);
    const float* mn = a.in[I_MOEN]; const float* br = a.in[I_BR];
    const int lane = F.lane, b5 = (lane >> 5) & 1, b4 = (lane >> 4) & 1, b3 = (lane >> 3) & 1, myt = 4 * b5 + 2 * b4 + b3;
    for (int chunk = blockIdx.x; chunk < NTOK / 64; chunk += F.G) {
        if (F.tid < 32) hist[F.tid] = 0;
        const int m0 = chunk * 64 + 8 * F.wave;
        float rsl = 0.f;
#pragma unroll
        for (int tk = 0; tk < 8; ++tk) { const int m = m0 + tk; const GAS f32x4* xr = (const GAS f32x4*)(X + (size_t)m * DM) + lane; const GAS v2u* dr = (const GAS v2u*)(DL + (size_t)m * DM) + lane; f32x4 v[8]; float ss = 0.f;
#pragma unroll
            for (int j = 0; j < 8; ++j) { const v2u d = dr[64 * j]; v[j] = xr[64 * j]; v[j].x += bflo(d.x); v[j].y += bfhi(d.x); v[j].z += bflo(d.y); v[j].w += bfhi(d.y); ss += (v[j].x * v[j].x + v[j].y * v[j].y) + (v[j].z * v[j].z + v[j].w * v[j].w); }
            const float r = 1.0f / sqrtf(wave_sum(ss) * (1.f / DM) + EPS);
            rsl = (tk == myt) ? r : rsl;
            { GAS v2u* xb = (GAS v2u*)(X1B + (size_t)m * DM) + lane;
#pragma unroll
              for (int j = 0; j < 8; ++j) { v2u o; o.x = pk2(v[j].x, v[j].y); o.y = pk2(v[j].z, v[j].w); xb[64 * j] = o; } }
            GAS unsigned* o8 = (GAS unsigned*)(H2 + (size_t)m * DM) + lane;
#pragma unroll
            for (int j = 0; j < 8; ++j) { const f32x4 g = ((const GAS f32x4*)mn)[lane + 64 * j]; o8[64 * j] = pg8::cvt4_fp8(v[j].x * r * g.x, v[j].y * r * g.y, v[j].z * r * g.z, v[j].w * r * g.w); } }
        for (int hh = 0; hh < 2; ++hh) {
            __syncthreads();
#pragma unroll 4
            for (int j = 0; j < 16; ++j) { const int idx4 = F.tid + 512 * j, e = idx4 >> 8, kq = idx4 & 255;
                const f32x4 w = *(const GAS f32x4*)(WRT + (size_t)e * DM + 1024 * hh + 4 * kq), g = *(const GAS f32x4*)(mn + 1024 * hh + 4 * kq);
                *(LAS f32x4*)(WL + e * 1024 + 4 * kq) = w * g; }
            asm volatile("" ::: "memory");
            __syncthreads();
#pragma unroll 1
            for (int grp = 0; grp < 2; ++grp) {
                f32x4 xv[4][4];
#pragma unroll
                for (int tk = 0; tk < 4; ++tk) { const int m = m0 + 4 * grp + tk; const GAS f32x4* xr = (const GAS f32x4*)(X + (size_t)m * DM + 1024 * hh) + lane; const GAS v2u* dr = (const GAS v2u*)(DL + (size_t)m * DM + 1024 * hh) + lane;
#pragma unroll
                    for (int j = 0; j < 4; ++j) { const v2u d = dr[64 * j]; f32x4 v = xr[64 * j]; v.x += bflo(d.x); v.y += bfhi(d.x); v.z += bflo(d.y); v.w += bfhi(d.y); xv[tk][j] = v; } }
#pragma unroll 1
                for (int eb = 0; eb < 32; eb += 8) {
                    float p[8][4];
#pragma unroll
                    for (int e8 = 0; e8 < 8; ++e8) { f32x4 w[4];
#pragma unroll
                        for (int j = 0; j < 4; ++j) w[j] = *(const LAS f32x4*)(WL + (eb + e8) * 1024 + 4 * lane + 256 * j);
#pragma unroll
                        for (int tk = 0; tk < 4; ++tk) p[e8][tk] = rt_dot16(xv[tk], w); }
                    float q[8][2], t1[8];
#pragma unroll
                    for (int e8 = 0; e8 < 8; ++e8)
#pragma unroll
                        for (int i = 0; i < 2; ++i) { const float send = b5 ? p[e8][i] : p[e8][i + 2], keep = b5 ? p[e8][i + 2] : p[e8][i]; q[e8][i] = keep + __shfl_xor(send, 32); }
#pragma unroll
                    for (int e8 = 0; e8 < 8; ++e8) { const float send = b4 ? q[e8][0] : q[e8][1], keep = b4 ? q[e8][1] : q[e8][0]; t1[e8] = keep + __shfl_xor(send, 16); }
#pragma unroll
                    for (int e8 = 0; e8 < 8; ++e8) t1[e8] += __shfl_xor(t1[e8], 8);
#pragma unroll
                    for (int e8 = 0; e8 < 8; ++e8) t1[e8] += __shfl_xor(t1[e8], 4);
#pragma unroll
                    for (int e8 = 0; e8 < 8; ++e8) t1[e8] += __shfl_xor(t1[e8], 2);
#pragma unroll
                    for (int e8 = 0; e8 < 8; ++e8) t1[e8] += __shfl_xor(t1[e8], 1);
                    if ((lane & 15) == 0) { LAS float* lp = lg + (8 * F.wave + 4 * grp + 2 * b5 + b4) * 33 + eb;
#pragma unroll
                        for (int e8 = 0; e8 < 8; ++e8) lp[e8] = hh ? (lp[e8] + t1[e8]) : t1[e8]; }
                }
            }
        }
        LDS_WAIT();
        if ((lane & 7) == 0) {
            float l[32];
#pragma unroll
            for (int e = 0; e < 32; ++e) l[e] = lg[(8 * F.wave + myt) * 33 + e] * rsl + br[e];
            int sel[4]; float val[4];
#pragma unroll
            for (int j = 0; j < 4; ++j) { float best = -3.0e38f; int bi = 0;
#pragma unroll
                for (int e = 0; e < 32; ++e) { if (l[e] > best) { best = l[e]; bi = e; } }
                sel[j] = bi; val[j] = best;
#pragma unroll
                for (int e = 0; e < 32; ++e) l[e] = (e == bi) ? -3.0e38f : l[e]; }
            const float e1 = expf(val[1] - val[0]), e2 = expf(val[2] - val[0]), e3 = expf(val[3] - val[0]); const float inv = 1.0f / (1.0f + e1 + e2 + e3);
            const float gt[4] = {inv, e1 * inv, e2 * inv, e3 * inv};
#pragma unroll
            for (int j = 0; j < 4; ++j) { const int slot = (8 * F.wave + myt) * 4 + j; const int rk = atomicAdd((int*)&hist[sel[j]], 1); asg_e[slot] = sel[j]; asg_rank[slot] = rk; asg_gate[slot] = gt[j]; }
        }
        __syncthreads();
        if (F.tid < 32) base[F.tid] = (int)atomicAdd(&ctl[CW_CNT + 64 * F.tid], (unsigned)hist[F.tid]);
        __syncthreads();
        if (F.tid < 256) { const int tok = chunk * 64 + (F.tid >> 2), j = F.tid & 3; const int e = asg_e[F.tid], pos = base[e] + asg_rank[F.tid];
            list[(size_t)e * CAP + pos] = tok; listg[(size_t)e * CAP + pos] = asg_gate[F.tid]; tok_e[tok * 4 + j] = e; tok_pos[tok * 4 + j] = pos; }
        __syncthreads();
    }
}

__device__ __forceinline__ int build_tiles(const Frame& F, const Args& a) {
    unsigned* ctl = (unsigned*)(a.ws + WS_CTL);
    LAS int* cnt = (LAS int*)(F.lds + TILES_OFF); LAS int* tstart = cnt + 32; LAS unsigned char* tileE = (LAS unsigned char*)(tstart + 64);
    LAS unsigned short* tperm = (LAS unsigned short*)(F.lds + TPERM_OFF);
    __syncthreads();
    if (F.tid < 64) { const int e = F.tid & 31; const int c = (int)__hip_atomic_load(&ctl[CW_CNT + 64 * e], __ATOMIC_RELAXED, __HIP_MEMORY_SCOPE_AGENT); const int nt = (c + 255) >> 8;
        const int hf = (nt > 0 && c - 256 * (nt - 1) <= 128) ? 1 : 0;
        int incl = nt, hincl = hf;
#pragma unroll
        for (int o = 1; o < 32; o <<= 1) { const int v = __shfl_up(incl, o), h = __shfl_up(hincl, o); if ((F.tid & 31) >= o) { incl += v; hincl += h; } }
        const int NT = __shfl(incl, (F.tid & 32) | 31), NH = __shfl(hincl, (F.tid & 32) | 31), NTf = NT - NH;
        if (F.tid < 32) { cnt[e] = c; tstart[e] = incl - nt; if (e == 31) { tstart[32] = incl; tstart[33] = NTf; }
            const int st = incl - nt, hp = hincl - hf;
            for (int t = st; t < incl; ++t) tileE[t] = (unsigned char)e;
            for (int j = 0; j < nt - hf; ++j) tperm[st - hp + j] = (unsigned short)(st + j);
            if (hf) tperm[NTf + hp] = (unsigned short)(incl - 1); } }
    __syncthreads();
    return tstart[32];
}
#define TILE_CNT(F)    ((LAS int*)((F).lds + TILES_OFF))
#define TILE_START(F)  ((LAS int*)((F).lds + TILES_OFF) + 32)
#define TILE_E(F)      ((LAS unsigned char*)((LAS int*)((F).lds + TILES_OFF) + 96))
#define TILE_PERM(F)   ((LAS unsigned short*)((F).lds + TPERM_OFF))
#define TILE_NFULL(F)  (((LAS int*)((F).lds + TILES_OFF))[32 + 33])

template <class Sched>
__device__ __forceinline__ void fill_tokidx(const Frame& F, const Args& a, const Sched& S) {
    const LAS int* cnt = TILE_CNT(F); const LAS int* tstart = TILE_START(F);
    const int* list = (const int*)(a.ws + WS_ROUTE + RT_LIST);
    LAS unsigned short* tk = (LAS unsigned short*)(F.lds + TOKIDX_OFF);
    pg8::Unit u;
    for (int i = F.tid >> 8; S.next(i, u) && u.slot < MAXU; i += 2) { const int r = F.tid & 255, pos = (u.pm - tstart[u.e]) * 256 + r;
        tk[u.slot * 256 + r] = (unsigned short)((pos < cnt[u.e]) ? list[(size_t)u.e * CAP + pos] : 0); }
    __syncthreads();
}

__device__ __forceinline__ void p8_final(const Frame& F, const Args& a) {
    (void)build_tiles(F, a);
    const LAS int* tstart = TILE_START(F);
    const bf16* X1B = (const bf16*)(a.ws + WS_OF); const unsigned char* Y = a.ws + WS_Y;
    const int* tok_e = (const int*)(a.ws + WS_ROUTE + RT_TOKE); const int* tok_pos = (const int*)(a.ws + WS_ROUTE + RT_TOKPOS);
    const float* fn = a.in[I_FIN];
    f32x4 fg[8];
#pragma unroll
    for (int j = 0; j < 8; ++j) fg[j] = ((const GAS f32x4*)fn)[F.lane + 64 * j];
    for (int m = F.gw; m < NTOK; m += F.NGW) {
        f32x4 v[8]; const GAS v2u* dr = (const GAS v2u*)(X1B + (size_t)m * DM) + F.lane;
#pragma unroll
        for (int j = 0; j < 8; ++j) { const v2u d = dr[64 * j]; v[j] = (f32x4){bflo(d.x), bfhi(d.x), bflo(d.y), bfhi(d.y)}; }
#pragma unroll
        for (int s = 0; s < 4; ++s) { const int e = tok_e[m * 4 + s], pos = tok_pos[m * 4 + s]; const size_t r = (size_t)tstart[e] * 256 + pos;
            const GAS unsigned* yp = (const GAS unsigned*)(Y + r * DM) + F.lane;
#pragma unroll
            for (int j = 0; j < 8; ++j) { const unsigned q = yp[64 * j]; const f32x2t lo = __builtin_amdgcn_cvt_pk_f32_fp8((int)q, false), hi = __builtin_amdgcn_cvt_pk_f32_fp8((int)q, true);
                v[j].x += lo.x; v[j].y += lo.y; v[j].z += hi.x; v[j].w += hi.y; } }
        float ss = 0.f;
#pragma unroll
        for (int j = 0; j < 8; ++j) ss += (v[j].x * v[j].x + v[j].y * v[j].y) + (v[j].z * v[j].z + v[j].w * v[j].w);
        const float r = 1.0f / sqrtf(wave_sum(ss) * (1.f / DM) + EPS);
        GAS f32x4* op = (GAS f32x4*)(a.out + (size_t)m * DM) + F.lane;
#pragma unroll
        for (int j = 0; j < 8; ++j) { const f32x4 g = fg[j]; f32x4 o; o.x = v[j].x * r * g.x; o.y = v[j].y * r * g.y; o.z = v[j].z * r * g.z; o.w = v[j].w * r * g.w; op[64 * j] = o; }
    }
}

constexpr int N_PHASES = 10;
__device__ __forceinline__ Args load_args() {
#if defined(__HIP_DEVICE_COMPILE__)
    const __attribute__((address_space(4))) unsigned char* p = (const __attribute__((address_space(4))) unsigned char*)__builtin_amdgcn_kernarg_segment_ptr();
    asm volatile("" : "+s"(p));
    return *(const __attribute__((address_space(4))) Args*)p;
#else
    return Args{};
#endif
}
__global__ void __launch_bounds__(NTHREADS, 2) fwd_kernel(Args kargs_) {
    extern __shared__ __attribute__((aligned(16))) unsigned char lds_raw[];
    Frame F;
    F.lds = (LAS unsigned char*)lds_raw;
    F.tid = threadIdx.x; F.lane = F.tid & 63; F.wave = __builtin_amdgcn_readfirstlane(F.tid >> 6);
    F.G = gridDim.x; F.gw = blockIdx.x * NWAVES + F.wave; F.NGW = F.G * NWAVES;
    volatile LAS unsigned* MISC = (volatile LAS unsigned*)(F.lds + MISC_OFF);
    if (F.tid < 16) MISC[F.tid] = 0u;
    __syncthreads();
    unsigned* ctl; int lo, hi; { const Args args = load_args(); ctl = (unsigned*)(args.ws + WS_CTL); lo = args.ph_lo; hi = args.ph_hi; }
    const bool multi = (hi - lo) > 1;
    XcdBarrier bar; bar.bar = ctl + CW_BAR; bar.x = 0; bar.st = nullptr;
    if (multi) bar = xcd_barrier_post(ctl + CW_BAR, MISC + 8);
#ifndef PHMASK
#define PHMASK 0x3ff
#endif
#define IN(k) (((PHMASK >> (k)) & 1) && lo <= (k) && (k) < hi)
#ifndef REPMASK
#define REPMASK 0
#endif
#define REP(k) (((REPMASK >> (k)) & 1) ? 2 : 1)
#define SEAM(k) do { if (IN(k) && IN((k) + 1)) xcd_barrier(bar); } while (0)

    if (IN(0)) { const Args args = load_args(); p0_prologue(F, args); }
    SEAM(0);
    if (IN(1)) { const Args args = load_args(); {
        const int GG = (F.G == 256) ? P1_GEMM_WGS : F.G;
        if ((int)blockIdx.x < GG) {
        pg8::StaticOrder S; S.init(args.ws + WS_H, args.ws + WS_WIN_T, NTOK, INC, DM, GG, (int)blockIdx.x);
        pg8::EpiZ E{(pg8::bf16_t*)(args.ws + WS_Z), INC};
        pg8::gemm_phase<pg8::EpiZ, pg8::StaticOrder>(F.lds + RING_OFF, DM, S, E);
        } else p0_expert_tiles(F, args, (int)blockIdx.x - GG, F.G - GG, P0_PRE_TILES, P0_PRE_TILES + P1_CONV_TILES);
    } }
    SEAM(1);
    if (IN(2)) { const Args args = load_args();
        for (int rep = 0; rep < REP(2); ++rep) { if (rep) xcd_barrier(bar);
        for (int it = blockIdx.x; it < 256; it += F.G) { if (it < 128) hgrn_full_item(F, args, it); else gmlp_full_item(F, args, it - 128); }
        { const int half = F.G / 2; if ((int)blockIdx.x >= half) { __syncthreads(); p0_expert_tiles(F, args, (int)blockIdx.x - half, F.G - half, P0_NTILES - P0_LATE_TILES, P0_NTILES); } } }
    }
    SEAM(2);
    if (IN(3)) { const Args args = load_args(); p3_cat(F, args); }
    SEAM(3);
    if (IN(4)) { const Args args = load_args(); {
        pg8::StaticOrder S; S.init(args.ws + WS_CAT, args.ws + WS_WOUT_T, NTOK, DM, DM, F.G, (int)blockIdx.x);
        pg8::EpiBf16Plain E{(pg8::bf16_t*)(args.ws + WS_X1), DM};
        pg8::gemm_phase<pg8::EpiBf16Plain, pg8::StaticOrder>(F.lds + RING_OFF, DM, S, E);
    } }
    SEAM(4);
    if (IN(5)) { const Args args = load_args(); p5_route(F, args); }
    do { if (IN(5) && IN(7)) xcd_barrier(bar); } while (0);
    if (IN(7)) { const Args args = load_args(); {
        const int NT = build_tiles(F, args), NTf = TILE_NFULL(F);
        pg8::GroupedOrder S; S.init(args.ws + WS_H, args.ws + WS_W1T, DM / 2, 16, NTf, TILE_E(F), TILE_PERM(F), 0, F.G, (int)blockIdx.x);
        pg8::GroupedOrder S2; S2.init(args.ws + WS_H, args.ws + WS_W1T, DM / 2, 16, NT - NTf, TILE_E(F), TILE_PERM(F), NTf, F.G, (int)blockIdx.x);
        S2.rot = S.nU % F.G; S2.slot0 = 40;
        fill_tokidx(F, args, S); fill_tokidx(F, args, S2);
        S.tokidx = (const LAS unsigned short*)(F.lds + TOKIDX_OFF); S2.tokidx = S.tokidx;
        pg8::EpiSwiglu E{args.ws + WS_ACT, args.in[I_B1]};
        pg8::gemm_phase<pg8::EpiSwiglu, pg8::GroupedOrder, true, true>(F.lds + RING_OFF, DM / 2, S, E);
        pg8::EpiSwigluT<true> E2{args.ws + WS_ACT, args.in[I_B1]};
        pg8::gemm_phase<pg8::EpiSwigluT<true>, pg8::GroupedOrder, true, true, true, true>(F.lds + RING_OFF, DM / 2, S2, E2);
    } }
    SEAM(7);
    if (IN(8)) { const Args args = load_args(); {
        const int NT = build_tiles(F, args), NTf = TILE_NFULL(F);
        pg8::GroupedOrder S; S.init(args.ws + WS_ACT, args.ws + WS_W2T, DEXP / 2, 8, NTf, TILE_E(F), TILE_PERM(F), 0, F.G, (int)blockIdx.x);
        S.pw = 8;
        pg8::GroupedOrder S2; S2.init(args.ws + WS_ACT, args.ws + WS_W2T, DEXP / 2, 8, NT - NTf, TILE_E(F), TILE_PERM(F), NTf, F.G, (int)blockIdx.x);
        S2.pw = 8; S2.rot = S.nU % F.G;
        pg8::EpiY E{args.ws + WS_Y, args.in[I_B2], (const float*)(args.ws + WS_ROUTE + RT_LISTG), TILE_START(F), CAP};
        pg8::gemm_phase<pg8::EpiY, pg8::GroupedOrder, true>(F.lds + RING_OFF, DEXP / 2, S, E);
        pg8::EpiYT<true> E2{args.ws + WS_Y, args.in[I_B2], (const float*)(args.ws + WS_ROUTE + RT_LISTG), TILE_START(F), CAP};
        pg8::gemm_phase<pg8::EpiYT<true>, pg8::GroupedOrder, true, false, true, true>(F.lds + RING_OFF, DEXP / 2, S2, E2);
    } }
    SEAM(8);
    if (IN(9)) { const Args args = load_args(); p8_final(F, args); }
#undef IN
#undef SEAM
}

extern "C" void kernel_launch(void* const* d_in, const int* in_sizes, int n_in, void* d_out, int out_size, void* d_ws, size_t ws_size, hipStream_t stream) {
    static int grid = 0;
    if (grid == 0) {
        if (n_in != 20 || out_size != NTOK * DM || ws_size < WS_END) { fprintf(stderr, "kernel_launch: unexpected shapes (n_in %d out %d ws %zu)\n", n_in, out_size, ws_size); grid = -1; return; }
        int dev = 0, cus = 0, per_cu = 0;
        if (hipGetDevice(&dev) != hipSuccess || hipDeviceGetAttribute(&cus, hipDeviceAttributeMultiprocessorCount, dev) != hipSuccess) { grid = -1; return; }
        if (hipFuncSetAttribute((const void*)fwd_kernel, hipFuncAttributeMaxDynamicSharedMemorySize, LDS_BYTES) != hipSuccess) { fprintf(stderr, "kernel_launch: hipFuncSetAttribute failed\n"); grid = -1; return; }
        if (hipOccupancyMaxActiveBlocksPerMultiprocessor(&per_cu, (const void*)fwd_kernel, NTHREADS, LDS_BYTES) != hipSuccess || per_cu < 1) { fprintf(stderr, "kernel_launch: occupancy query says %d\n", per_cu); }
        (void)hipGetLastError();
        grid = cus;
    }
    if (grid < 0) return;
    (void)hipMemsetAsync((char*)d_ws + WS_CTL, 0, CTL_ZERO_BYTES, stream);
    Args a{};
    for (int i = 0; i < 20; ++i) a.in[i] = (const float*)d_in[i];
    a.out = (float*)d_out; a.ws = (unsigned char*)d_ws;
#if MK_N_LAUNCHES == 1
    a.ph_lo = 0; a.ph_hi = N_PHASES;
    hipLaunchKernelGGL(fwd_kernel, dim3(grid), dim3(NTHREADS), LDS_BYTES, stream, a);
#else
    for (int p = 0; p < N_PHASES; ++p) { a.ph_lo = p; a.ph_hi = p + 1; hipLaunchKernelGGL(fwd_kernel, dim3(grid), dim3(NTHREADS), LDS_BYTES, stream, a); }
#endif
}
```

```cpp
#include <hip/hip_runtime.h>
#include <cstdio>
#include <cstdint>

#ifndef MK_N_LAUNCHES
#define MK_N_LAUNCHES 1
#endif

namespace pg8 {
#define PG8_LAS __attribute__((address_space(3)))
typedef unsigned short bf16_t;
typedef short bf16x8 __attribute__((ext_vector_type(8)));
typedef float f32x4 __attribute__((ext_vector_type(4)));
typedef float f32x2 __attribute__((ext_vector_type(2)));
typedef unsigned u32x4 __attribute__((ext_vector_type(4)));
typedef unsigned u32x2 __attribute__((ext_vector_type(2)));
typedef int v4i_t __attribute__((ext_vector_type(4)));
typedef int v8i_t __attribute__((ext_vector_type(8)));
constexpr int BM = 256, BK = 64, HALF = 128, HTB = HALF * BK * 2, STAGE_BYTES = 8 * HTB, NXCD = 8, WGM = 8;

__host__ __device__ __forceinline__ int lds_byte(int r, int c) { const int st = (r >> 4) * 2 + (c >> 5), rr = r & 15, cc = c & 31, ob = rr * 64 + cc * 2; return st * 1024 + (ob ^ (((ob >> 9) & 1) << 5)); }
__host__ __device__ __forceinline__ void stage_rc(int b, int& R, int& C) { const int st = b / 1024, sb = b % 1024, swz = sb ^ (((sb >> 9) & 1) << 5); R = (st >> 1) * 16 + swz / 64; C = (st & 1) * 32 + (swz % 64) / 2; }
__host__ __device__ __forceinline__ int perm32(int rho) { const int n = rho >> 4, i = rho & 15; return 8 * (i >> 2) + 4 * n + (i & 3); }

struct Unit { int pm, pn, e, slot; };

struct StaticOrder {
    const char* A; const char* Bt; size_t tstep;
    int nM, nN, nwg, G, c;
    __device__ void init(const void* A_, const void* Bt_, int M, int N, int K, int G_, int c_) { A = (const char*)A_; Bt = (const char*)Bt_; tstep = (size_t)BM * K * 2; nM = M / BM; nN = N / BM; nwg = nM * nN; G = G_; c = c_; }
    __device__ bool next(int i, Unit& u) const {
        const long L = (long)i * G + c; if (L >= nwg) return false;
        int wgid = (int)L; { const int q = nwg / NXCD, r = nwg % NXCD, xcd = wgid % NXCD, off = wgid / NXCD; wgid = (xcd < r ? xcd * (q + 1) : r * (q + 1) + (xcd - r) * q) + off; }
        const int nig = WGM * nN, gid = wgid / nig, fm = gid * WGM, gsz = (nM - fm) < WGM ? (nM - fm) : WGM;
        u.pm = fm + ((wgid % nig) % gsz); u.pn = (wgid % nig) / gsz; u.e = 0; u.slot = i; return true;
    }
    __device__ __forceinline__ const char* abase(const Unit& u) const { return A + (size_t)u.pm * tstep; }
    __device__ __forceinline__ const char* bbase(const Unit& u) const { return Bt + (size_t)u.pn * tstep; }
};
struct GroupedOrder {
    const char* A; const char* Bt; size_t tstep, estep;
    const PG8_LAS unsigned char* tileE; const PG8_LAS unsigned short* tokidx; int NT, nN, nU, G, c, pw;
    __device__ void init(const void* A_, const void* Bt_, int K, int nN_, int NT_, const PG8_LAS unsigned char* tileE_, int G_, int c_) {
        A = (const char*)A_; Bt = (const char*)Bt_; tstep = (size_t)BM * K * 2; estep = (size_t)nN_ * tstep; tileE = tileE_; tokidx = nullptr; NT = NT_; nN = nN_; nU = NT_ * nN_; G = G_; c = c_; pw = 4; }
    __device__ bool next(int i, Unit& u) const {
        const int L = i * G + ((G % 8 == 0) ? ((c % 8) * (G / 8) + c / 8) : c); if (L >= nU) return false;
        const int png = L / (NT * pw), rem = L % (NT * pw); u.pm = rem / pw; u.pn = png * pw + (rem % pw); u.e = tileE[u.pm]; u.slot = i; return true;
    }
    __device__ __forceinline__ const char* abase(const Unit& u) const { return tokidx ? A : A + (size_t)u.pm * tstep; }
    __device__ __forceinline__ const char* bbase(const Unit& u) const { return Bt + (size_t)u.e * estep + (size_t)u.pn * tstep; }
};

__device__ __forceinline__ unsigned cvt_pk_bf16(float lo, float hi) { unsigned r; asm volatile("v_cvt_pk_bf16_f32 %0, %1, %2" : "=v"(r) : "v"(lo), "v"(hi)); return r; }
__device__ __forceinline__ f32x2 gelu_pk(f32x2 v) {
    const f32x2 av = __builtin_elementwise_abs(v), d = av * 0.2316418882f + 1.0f;
    f32x2 t; t.x = __builtin_amdgcn_rcpf(d.x); t.y = __builtin_amdgcn_rcpf(d.y);
    f32x2 q = t * 0.5307027145f + (-0.7265760135f); q = q * t + 0.7107068705f; q = q * t + (-0.142248368f); q = q * t + 0.127414796f; q = q * t;
    const f32x2 s = (v * v) * (-0.72134752044f);
    f32x2 e; e.x = __builtin_amdgcn_exp2f(s.x); e.y = __builtin_amdgcn_exp2f(s.y);
    const f32x2 m = v * (q * e), r = v - m;
    f32x2 o; o.x = v.x < 0.f ? m.x : r.x; o.y = v.y < 0.f ? m.y : r.y; return o;
}
__device__ __forceinline__ float sigmoidf_fast(float x) { return __builtin_amdgcn_rcpf(1.0f + __builtin_amdgcn_exp2f(-1.44269504089f * x)); }
__device__ __forceinline__ float siluf_fast(float x) { return x * sigmoidf_fast(x); }


struct EpiZ {
    static constexpr bool PERM = true; static constexpr int NSTAGE = 0;
    __device__ __forceinline__ void stage(const Unit&, PG8_LAS unsigned char*, int) const {}
    bf16_t* O; int ldc;
    __device__ __forceinline__ void operator()(const f32x4 (&acc)[2][2][4][2], const Unit& u, int wr, int wc, int fr, int fq, const PG8_LAS float* sb) const {
        const int row0 = u.pm * BM + wr * 64 + fr, col0 = u.pn * BM + wc * 32 + 8 * fq;
        const int act = (u.pn < 8) ? 1 : ((u.pn < 12 || u.pn >= 24) ? 2 : 0);
#pragma unroll
        for (int ai = 0; ai < 2; ++ai)
#pragma unroll
            for (int m = 0; m < 4; ++m) { bf16_t* rowp = O + (size_t)(row0 + ai * HALF + m * 16) * ldc + col0;
#pragma unroll
                for (int bj = 0; bj < 2; ++bj) { f32x4 v0 = acc[ai][bj][m][0], v1 = acc[ai][bj][m][1];
                    if (act == 1) { f32x2 a = gelu_pk((f32x2){v0[0], v0[1]}), b = gelu_pk((f32x2){v0[2], v0[3]}), c = gelu_pk((f32x2){v1[0], v1[1]}), d = gelu_pk((f32x2){v1[2], v1[3]});
                        v0 = (f32x4){a.x, a.y, b.x, b.y}; v1 = (f32x4){c.x, c.y, d.x, d.y}; }
                    else if (act == 2) {
#pragma unroll
                        for (int j = 0; j < 4; ++j) { v0[j] = siluf_fast(v0[j]); v1[j] = siluf_fast(v1[j]); } }
                    u32x4 w; w.x = cvt_pk_bf16(v0[0], v0[1]); w.y = cvt_pk_bf16(v0[2], v0[3]); w.z = cvt_pk_bf16(v1[0], v1[1]); w.w = cvt_pk_bf16(v1[2], v1[3]);
                    *(u32x4*)(rowp + bj * HALF) = w; } }
    }
};
struct EpiBf16Plain {
    static constexpr bool PERM = true; static constexpr int NSTAGE = 0;
    __device__ __forceinline__ void stage(const Unit&, PG8_LAS unsigned char*, int) const {}
    bf16_t* O; int ldc;
    __device__ __forceinline__ void operator()(const f32x4 (&acc)[2][2][4][2], const Unit& u, int wr, int wc, int fr, int fq, const PG8_LAS float* sb) const {
        const int row0 = u.pm * BM + wr * 64 + fr, col0 = u.pn * BM + wc * 32 + 8 * fq;
#pragma unroll
        for (int ai = 0; ai < 2; ++ai)
#pragma unroll
            for (int m = 0; m < 4; ++m) { bf16_t* rowp = O + (size_t)(row0 + ai * HALF + m * 16) * ldc + col0;
#pragma unroll
                for (int bj = 0; bj < 2; ++bj) { const f32x4 v0 = acc[ai][bj][m][0], v1 = acc[ai][bj][m][1];
                    u32x4 w; w.x = cvt_pk_bf16(v0[0], v0[1]); w.y = cvt_pk_bf16(v0[2], v0[3]); w.z = cvt_pk_bf16(v1[0], v1[1]); w.w = cvt_pk_bf16(v1[2], v1[3]);
                    *(u32x4*)(rowp + bj * HALF) = w; } }
    }
};
constexpr float W8_SCALE = 32.0f, W8_INV = 1.0f / 32.0f;
__device__ __forceinline__ unsigned cvt4_fp8(float a, float b, float c, float d) { int r = 0; r = __builtin_amdgcn_cvt_pk_fp8_f32(a, b, r, false); r = __builtin_amdgcn_cvt_pk_fp8_f32(c, d, r, true); return (unsigned)r; }
struct EpiSwiglu {
    static constexpr bool PERM = true; static constexpr int NSTAGE = 1;
    unsigned char* O; const float* b1;
    __device__ __forceinline__ void stage(const Unit& u, PG8_LAS unsigned char* buf, int lane) const {
        __builtin_amdgcn_global_load_lds((const unsigned*)(b1 + (size_t)u.e * 4096 + (size_t)u.pn * 256 + 4 * lane), (PG8_LAS unsigned*)buf, 16, 0, 0); }
    __device__ __forceinline__ void operator()(const f32x4 (&acc)[2][2][4][2], const Unit& u, int wr, int wc, int fr, int fq, const PG8_LAS float* sb) const {
        const int row0 = u.pm * BM + wr * 64 + fr, j0 = u.pn * HALF + wc * 32 + 8 * fq;
        const PG8_LAS float* bp = sb + 64 * wc + 16 * fq;
        const f32x4 q0 = *(const PG8_LAS f32x4*)(bp), q1 = *(const PG8_LAS f32x4*)(bp + 4), q2 = *(const PG8_LAS f32x4*)(bp + 8), q3 = *(const PG8_LAS f32x4*)(bp + 12);
        const f32x4 bg0 = (f32x4){q0[0], q0[2], q1[0], q1[2]}, bl0 = (f32x4){q0[1], q0[3], q1[1], q1[3]};
        const f32x4 bg1 = (f32x4){q2[0], q2[2], q3[0], q3[2]}, bl1 = (f32x4){q2[1], q2[3], q3[1], q3[3]};
        const f32x4 bl0p = bl0 + 1.0f, bl1p = bl1 + 1.0f;
#pragma unroll
        for (int ai = 0; ai < 2; ++ai)
#pragma unroll
            for (int m = 0; m < 4; ++m) { unsigned char* rowp = O + (size_t)(row0 + ai * HALF + m * 16) * 2048 + j0;
                f32x4 o[2];
#pragma unroll
                for (int n = 0; n < 2; ++n) { const f32x4 g = acc[ai][0][m][n] * W8_INV + (n ? bg1 : bg0), l = acc[ai][1][m][n] * W8_INV + (n ? bl1p : bl0p);
#pragma unroll
                    for (int j = 0; j < 4; ++j) { const float gg = fminf(g[j], 7.0f), ll1 = fminf(fmaxf(l[j], -6.0f), 8.0f);
                        o[n][j] = gg * __builtin_amdgcn_rcpf(1.0f + __builtin_amdgcn_exp2f(gg * (-1.702f * 1.44269504089f))) * ll1; } }
                u32x2 w; w.x = cvt4_fp8(o[0][0], o[0][1], o[0][2], o[0][3]); w.y = cvt4_fp8(o[1][0], o[1][1], o[1][2], o[1][3]);
                *(u32x2*)rowp = w; }
    }
};
struct EpiY {
    static constexpr bool PERM = true; static constexpr int NSTAGE = 2;
    unsigned char* O; const float* b2; const float* listg; const PG8_LAS int* tstart; int cap;
    __device__ __forceinline__ void stage(const Unit& u, PG8_LAS unsigned char* buf, int lane) const {
        __builtin_amdgcn_global_load_lds((const unsigned*)(b2 + (size_t)u.e * 2048 + (size_t)u.pn * 256 + 4 * lane), (PG8_LAS unsigned*)buf, 16, 0, 0);
        __builtin_amdgcn_global_load_lds((const unsigned*)(listg + (size_t)u.e * cap + (size_t)(u.pm - tstart[u.e]) * 256 + 4 * lane), (PG8_LAS unsigned*)(buf + 1024), 16, 0, 0); }
    __device__ __forceinline__ void operator()(const f32x4 (&acc)[2][2][4][2], const Unit& u, int wr, int wc, int fr, int fq, const PG8_LAS float* sb) const {
        const int rl0 = wr * 64 + fr, row0 = u.pm * BM + rl0, col0 = u.pn * BM + wc * 32 + 8 * fq;
        const PG8_LAS float* bp = sb + wc * 32 + 8 * fq;
        const PG8_LAS float* gp = sb + 256 + rl0;
        f32x4 bv[2][2]; float gts[2][4];
#pragma unroll
        for (int bj = 0; bj < 2; ++bj)
#pragma unroll
            for (int n = 0; n < 2; ++n) bv[bj][n] = *(const PG8_LAS f32x4*)(bp + bj * HALF + 4 * n) * W8_SCALE;
#pragma unroll
        for (int ai = 0; ai < 2; ++ai)
#pragma unroll
            for (int m = 0; m < 4; ++m) gts[ai][m] = gp[ai * HALF + m * 16] * W8_INV;
#pragma unroll
        for (int ai = 0; ai < 2; ++ai)
#pragma unroll
            for (int m = 0; m < 4; ++m) { const int r = row0 + ai * HALF + m * 16; const float gt = gts[ai][m]; unsigned char* rowp = O + (size_t)r * 2048 + col0;
#pragma unroll
                for (int bj = 0; bj < 2; ++bj) { const f32x4 v0 = (acc[ai][bj][m][0] + bv[bj][0]) * gt, v1 = (acc[ai][bj][m][1] + bv[bj][1]) * gt;
                    u32x2 w; w.x = cvt4_fp8(v0[0], v0[1], v0[2], v0[3]); w.y = cvt4_fp8(v1[0], v1[1], v1[2], v1[3]);
                    *(u32x2*)(rowp + bj * HALF) = w; } }
    }
};

template <class Epi, class Sched, bool FP8 = false, bool GATHER = false, bool ALIGN_EPI = true>
__device__ __forceinline__ void gemm_phase(PG8_LAS unsigned char* lds, const int K, const Sched& S, const Epi& E, PG8_LAS unsigned char* ebuf = nullptr) {
    const int tid = threadIdx.x, wid = __builtin_amdgcn_readfirstlane(tid >> 6), lane = tid & 63, wr = wid >> 2, wc = wid & 3, fr = lane & 15, fq = lane >> 4;
    const int nt = K / BK;
    unsigned voffA[2][2], voffAn[2][2], voffB[2]; int stR[2], stC[2];
#pragma unroll
    for (int i = 0; i < 2; ++i) { int R, C; stage_rc(tid * 16 + i * 8192, R, C); const int Rb = Epi::PERM ? ((R & ~31) + perm32(R & 31)) : R; stR[i] = R; stC[i] = C;
        voffB[i] = (unsigned)(Rb * K + C) * 2u;
#pragma unroll
        for (int h = 0; h < 2; ++h) { voffA[h][i] = (unsigned)((R + h * HALF) * K + C) * 2u; voffAn[h][i] = voffA[h][i]; } }
#define PG8_GATHER_OFFS(dst, u) do { if constexpr (GATHER) { const PG8_LAS unsigned short* _tk = S.tokidx + (u).slot * 256; _Pragma("unroll") for (int h = 0; h < 2; ++h) _Pragma("unroll") for (int i = 0; i < 2; ++i) \
        dst[h][i] = ((unsigned)_tk[stR[i] + h * HALF] * (unsigned)K + (unsigned)stC[i]) * 2u; } } while (0)
    const size_t kstep = (size_t)(BK * 2);
    const size_t hstep = (size_t)HALF * K * 2;
    const unsigned ldsw = (unsigned)wid * 1024u;
    const int aoff = lds_byte(wr * 64 + fr, fq * 8), boff = lds_byte(wc * 32 + fr, fq * 8);
#define PG8_SA(b, h) (((b) * 2 + (h)) * HTB)
#define PG8_SB(b, h) ((4 + (b) * 2 + (h)) * HTB)
#define PG8_STAGE(bufoff, gbase, voff) do { _Pragma("unroll") for (int _i = 0; _i < 2; ++_i) \
        __builtin_amdgcn_global_load_lds((const unsigned*)((const char*)(gbase) + (voff)[_i]), (PG8_LAS unsigned*)(lds + (bufoff) + ldsw + _i * 8192), 16, 0, 0); } while (0)
#define PG8_LD16(off) (*(const PG8_LAS bf16x8*)(lds + (off)))
#define PG8_CAT8(x, y) __builtin_shufflevector(__builtin_bit_cast(v4i_t, (x)), __builtin_bit_cast(v4i_t, (y)), 0, 1, 2, 3, 4, 5, 6, 7)
#define PG8_LDA(dst, b, h) do { if constexpr (FP8) { _Pragma("unroll") for (int m = 0; m < 4; ++m) dst##8[m] = PG8_CAT8(PG8_LD16(PG8_SA(b, h) + aoff + m * 2048), PG8_LD16(PG8_SA(b, h) + aoff + m * 2048 + 1024)); } \
        else { _Pragma("unroll") for (int m = 0; m < 4; ++m) _Pragma("unroll") for (int k = 0; k < 2; ++k) dst[m][k] = PG8_LD16(PG8_SA(b, h) + aoff + m * 2048 + k * 1024); } } while (0)
#define PG8_LDB(dst, b, h) do { if constexpr (FP8) { _Pragma("unroll") for (int n = 0; n < 2; ++n) dst##8[n] = PG8_CAT8(PG8_LD16(PG8_SB(b, h) + boff + n * 2048), PG8_LD16(PG8_SB(b, h) + boff + n * 2048 + 1024)); } \
        else { _Pragma("unroll") for (int n = 0; n < 2; ++n) _Pragma("unroll") for (int k = 0; k < 2; ++k) dst[n][k] = PG8_LD16(PG8_SB(b, h) + boff + n * 2048 + k * 1024); } } while (0)
#define PG8_MMA(ai, bj, At, Bt) do { __builtin_amdgcn_s_setprio(1); \
        if constexpr (FP8) { _Pragma("unroll") for (int m = 0; m < 4; ++m) _Pragma("unroll") for (int n = 0; n < 2; ++n) { \
            asm volatile("v_mfma_f32_16x16x128_f8f6f4 %0, %1, %2, %0" : "+v"(acc[ai][bj][m][n]) : "v"(Bt##8[n]), "v"(At##8[m])); } } \
        else { _Pragma("unroll") for (int m = 0; m < 4; ++m) _Pragma("unroll") for (int n = 0; n < 2; ++n) _Pragma("unroll") for (int k = 0; k < 2; ++k) \
            acc[ai][bj][m][n] = __builtin_amdgcn_mfma_f32_16x16x32_bf16(Bt[n][k], At[m][k], acc[ai][bj][m][n], 0, 0, 0); } \
        __builtin_amdgcn_s_setprio(0); } while (0)
#define PG8_WAIT_V(n) asm volatile("s_waitcnt vmcnt(" #n ")" ::: "memory")
#define PG8_WAIT_L(n) asm volatile("s_waitcnt lgkmcnt(" #n ")" ::: "memory")
#define PG8_BAR __builtin_amdgcn_s_barrier()
#define PG8_SCHED __builtin_amdgcn_sched_barrier(0)
    Unit cur, nxt; int ui = 0;
    if (!S.next(0, cur)) return;
    f32x4 acc[2][2][4][2];
#pragma unroll
    for (int a = 0; a < 2; ++a)
#pragma unroll
        for (int b = 0; b < 2; ++b)
#pragma unroll
            for (int m = 0; m < 4; ++m)
#pragma unroll
                for (int n = 0; n < 2; ++n) acc[a][b][m][n] = (f32x4){0.f, 0.f, 0.f, 0.f};
    bf16x8 At[4][2], B0[2][2], B1[2][2]; v8i_t At8[4], B08[2], B18[2];
    const char* cA = S.abase(cur); const char* cB = S.bbase(cur);
    PG8_GATHER_OFFS(voffA, cur);
    PG8_STAGE(PG8_SB(0, 0), cB, voffB); PG8_STAGE(PG8_SB(0, 1), cB + hstep, voffB); PG8_STAGE(PG8_SA(0, 0), cA, voffA[0]); PG8_STAGE(PG8_SA(0, 1), cA, voffA[1]);
    if (wr == 1) PG8_BAR;
    PG8_WAIT_V(2); PG8_BAR;
    PG8_STAGE(PG8_SB(1, 0), cB + kstep, voffB); PG8_STAGE(PG8_SA(1, 0), cA + kstep, voffA[0]); PG8_STAGE(PG8_SB(1, 1), cB + hstep + kstep, voffB);
    PG8_WAIT_V(6); PG8_BAR;
    for (;;) {
        if constexpr (Epi::NSTAGE > 0) { if (wid == 0) E.stage(cur, ebuf + (ui & 1) * 2048, lane); }
        const bool has_next = S.next(ui + 1, nxt);
        const char* nA = has_next ? S.abase(nxt) : cA; const char* nB = has_next ? S.bbase(nxt) : cB;
        if constexpr (GATHER) { if (has_next) PG8_GATHER_OFFS(voffAn, nxt); else {
#pragma unroll
            for (int h = 0; h < 2; ++h)
#pragma unroll
                for (int i = 0; i < 2; ++i) voffAn[h][i] = voffA[h][i]; } }
        for (int t = 0; t < nt; t += 2) {
            const bool last = (t == nt - 2);
            const char* a1 = cA + (size_t)(t + 1) * kstep;
            const char* a2 = last ? nA : cA + (size_t)(t + 2) * kstep; const char* b2 = last ? nB : cB + (size_t)(t + 2) * kstep;
            const char* a3 = a2 + kstep; const char* b3 = b2 + kstep;
            unsigned vA2[2][2];
#pragma unroll
            for (int h = 0; h < 2; ++h)
#pragma unroll
                for (int i = 0; i < 2; ++i) vA2[h][i] = (GATHER && last) ? voffAn[h][i] : voffA[h][i];
            PG8_LDB(B0, 0, 0); PG8_LDB(B1, 0, 1); PG8_SCHED; PG8_LDA(At, 0, 0); PG8_STAGE(PG8_SA(1, 1), a1, voffA[1]);
            PG8_WAIT_V(8); PG8_WAIT_L(0); PG8_BAR; PG8_MMA(0, 0, At, B0); PG8_MMA(0, 1, At, B1); PG8_BAR; PG8_SCHED;
            PG8_LDA(At, 0, 1); PG8_STAGE(PG8_SB(0, 0), b2, voffB); PG8_STAGE(PG8_SB(0, 1), b2 + hstep, voffB); PG8_STAGE(PG8_SA(0, 0), a2, vA2[0]);
            PG8_WAIT_V(8); PG8_WAIT_L(0); PG8_BAR; PG8_MMA(1, 0, At, B0); PG8_MMA(1, 1, At, B1); PG8_BAR; PG8_SCHED;
            PG8_LDB(B0, 1, 0); PG8_LDB(B1, 1, 1); PG8_SCHED; PG8_LDA(At, 1, 0); PG8_STAGE(PG8_SA(0, 1), a2, vA2[1]);
            PG8_WAIT_V(8); PG8_WAIT_L(0); PG8_BAR; PG8_MMA(0, 0, At, B0); PG8_MMA(0, 1, At, B1); PG8_BAR; PG8_SCHED;
            PG8_LDA(At, 1, 1); PG8_STAGE(PG8_SB(1, 0), b3, voffB); PG8_STAGE(PG8_SB(1, 1), b3 + hstep, voffB); PG8_STAGE(PG8_SA(1, 0), a3, vA2[0]);
            PG8_WAIT_V(8); PG8_WAIT_L(0); PG8_BAR; PG8_MMA(1, 0, At, B0); PG8_MMA(1, 1, At, B1); PG8_BAR; PG8_SCHED;
        }
        if constexpr (ALIGN_EPI) { if (wr == 0) PG8_BAR; }
        if constexpr (FP8) {
            asm volatile("s_nop 15\n\ts_nop 3" ::: "memory");
#pragma unroll
            for (int a = 0; a < 2; ++a)
#pragma unroll
                for (int b = 0; b < 2; ++b)
                    asm volatile("" : "+v"(acc[a][b][0][0]), "+v"(acc[a][b][0][1]), "+v"(acc[a][b][1][0]), "+v"(acc[a][b][1][1]), "+v"(acc[a][b][2][0]), "+v"(acc[a][b][2][1]), "+v"(acc[a][b][3][0]), "+v"(acc[a][b][3][1]));
        }
        E(acc, cur, wr, wc, fr, fq, (const PG8_LAS float*)(ebuf + (ui & 1) * 2048));
        if (!has_next) break;
#pragma unroll
        for (int a = 0; a < 2; ++a)
#pragma unroll
            for (int b = 0; b < 2; ++b)
#pragma unroll
                for (int m = 0; m < 4; ++m)
#pragma unroll
                    for (int n = 0; n < 2; ++n) acc[a][b][m][n] = (f32x4){0.f, 0.f, 0.f, 0.f};
        cur = nxt; cA = nA; cB = nB; ++ui;
        if constexpr (GATHER) {
#pragma unroll
            for (int h = 0; h < 2; ++h)
#pragma unroll
                for (int i = 0; i < 2; ++i) voffA[h][i] = voffAn[h][i]; }
        if constexpr (ALIGN_EPI) { if (wr == 1) PG8_BAR; }
    }
    PG8_WAIT_V(0);
    if constexpr (!ALIGN_EPI) { if (wr == 0) PG8_BAR; }
    PG8_BAR;
#undef PG8_SA
#undef PG8_SB
#undef PG8_STAGE
#undef PG8_LDA
#undef PG8_LDB
#undef PG8_MMA
#undef PG8_CAT8
#undef PG8_GATHER_OFFS
#undef PG8_LD16
#undef PG8_WAIT_V
#undef PG8_WAIT_L
#undef PG8_BAR
#undef PG8_SCHED
}
}

constexpr int NB = 8, SEQ = 2048, DM = 2048, NTOK = NB * SEQ, INC = 7168, DA = 1024, NEXP = 32, TOPK = 4, DEXP = 2048;
constexpr int CAP = 16384;
constexpr int MAXT = NTOK * TOPK / 256 + NEXP;
constexpr int PROWS = MAXT * 256;
constexpr float EPS = 1e-5f;
constexpr int ZU = 0, ZV = 1024, ZQ = 2048, ZFF = 3072, ZFB = 4096, ZI = 5120, ZG = 6144;
constexpr int NWAVES = 8, NTHREADS = 512;

constexpr size_t MiB = 1u << 20;
constexpr size_t WS_CTL = 0, CTL_ZERO_BYTES = 64 * 1024;
constexpr size_t WS_WIN_T = 1 * MiB;
constexpr size_t WS_WOUT_T = 29 * MiB;
constexpr size_t WS_WRT = 37 * MiB;
constexpr size_t WS_H = 38 * MiB;
constexpr size_t WS_Z = 102 * MiB;
constexpr size_t WS_ARAW = 326 * MiB;
constexpr size_t WS_OF = 358 * MiB;
constexpr size_t WS_OB = 422 * MiB;
constexpr size_t WS_CAT = 486 * MiB;
constexpr size_t WS_X1 = 550 * MiB;
constexpr size_t WS_ROUTE = 678 * MiB;
constexpr size_t RT_TOKE = 0, RT_TOKPOS = 256 * 1024, RT_ROWG = 512 * 1024, RT_LIST = 1 * MiB, RT_LISTG = 3 * MiB, RT_END = 5 * MiB;
static_assert(RT_ROWG + (size_t)PROWS * 4 <= RT_LIST && RT_LIST + (size_t)NEXP * CAP * 4 <= RT_LISTG && RT_LISTG + (size_t)NEXP * CAP * 4 <= RT_END && RT_END <= 8 * MiB, "route map");
constexpr size_t WS_XG = 686 * MiB;
constexpr size_t WS_ACT = 830 * MiB;
constexpr size_t WS_Y = 974 * MiB;
constexpr size_t WS_W1T = 1262 * MiB;
constexpr size_t WS_W2T = 1518 * MiB;
constexpr size_t WS_END = 1646 * MiB;
static_assert(WS_WIN_T + (size_t)INC * DM * 2 <= WS_WOUT_T && WS_WOUT_T + (size_t)DM * DM * 2 <= WS_WRT && WS_WRT + (size_t)NEXP * DM * 4 <= WS_H && WS_H + (size_t)NTOK * DM * 2 <= WS_Z &&
              WS_Z + (size_t)NTOK * INC * 2 <= WS_ARAW && WS_ARAW + (size_t)NTOK * DA * 2 <= WS_OF && WS_OF + (size_t)NTOK * DA * 4 <= WS_OB && WS_OB + (size_t)NTOK * DA * 4 <= WS_CAT &&
              WS_CAT + (size_t)NTOK * DM * 2 <= WS_X1 && WS_X1 + (size_t)NTOK * DM * 4 <= WS_ROUTE && WS_ROUTE + 8 * MiB <= WS_XG && WS_XG + (size_t)PROWS * DM <= WS_ACT &&
              WS_ACT + (size_t)PROWS * DEXP <= WS_Y && WS_Y + (size_t)PROWS * DM * 2 <= WS_W1T && WS_W1T + (size_t)NEXP * 4096 * DM <= WS_W2T && WS_W2T + (size_t)NEXP * DM * DEXP <= WS_END, "ws map");
constexpr int CW_BAR = 4096;
constexpr int CW_CNT = 8192;
constexpr int CW_TQ = 12288;
constexpr int CW_PF = 12352;

constexpr int RING_OFF = 0, RING_BYTES = 131072;
constexpr int LDS_BYTES = 163840;
constexpr int MISC_OFF = LDS_BYTES - 64;
constexpr int SMALL_OFF = RING_BYTES, SMALL_BYTES = MISC_OFF - RING_BYTES;
constexpr int P0_TILE_BYTES_MAX = (128 * 260 + 16) * 4;
constexpr int TILES_OFF = MISC_OFF - 1024;
constexpr int TOKIDX_OFF = SMALL_OFF + 1024;
constexpr int MAXU = 48;
constexpr int EBUF_OFF = TOKIDX_OFF + MAXU * 512;
static_assert(EBUF_OFF + 4096 <= TILES_OFF && TILES_OFF >= P0_TILE_BYTES_MAX, "LDS map");
#define LBAR() do { asm volatile("s_waitcnt lgkmcnt(0)" ::: "memory"); __builtin_amdgcn_s_barrier(); asm volatile("" ::: "memory"); } while (0)

#define GAS __attribute__((address_space(1)))
#define LAS __attribute__((address_space(3)))
typedef unsigned short bf16;
typedef unsigned v4u __attribute__((ext_vector_type(4)));
typedef unsigned v2u __attribute__((ext_vector_type(2)));
typedef float f32x4 __attribute__((ext_vector_type(4)));
typedef float f32x2t __attribute__((ext_vector_type(2)));
#define LDS_WAIT() asm volatile("s_waitcnt lgkmcnt(0)" ::: "memory")
#define VM_WAIT() asm volatile("s_waitcnt vmcnt(0)" ::: "memory")
__device__ __forceinline__ unsigned f2bf(float f) { unsigned u = __builtin_bit_cast(unsigned, f); return (u + 0x7fffu + ((u >> 16) & 1u)) >> 16; }
typedef __bf16 bf16x2_t __attribute__((ext_vector_type(2)));
__device__ __forceinline__ unsigned pk2(float lo, float hi) { const f32x2t v = {lo, hi}; const bf16x2_t b = __builtin_convertvector(v, bf16x2_t); return __builtin_bit_cast(unsigned, b); }
__device__ __forceinline__ float bf2f(unsigned short b) { return __builtin_bit_cast(float, (unsigned)b << 16); }
__device__ __forceinline__ float bflo(unsigned w) { return __builtin_bit_cast(float, w << 16); }
__device__ __forceinline__ float bfhi(unsigned w) { return __builtin_bit_cast(float, w & 0xffff0000u); }
__device__ __forceinline__ void unpack16(const v4u q0, const v4u q1, float (&x)[16]) {
    x[0] = bflo(q0.x); x[1] = bfhi(q0.x); x[2] = bflo(q0.y); x[3] = bfhi(q0.y); x[4] = bflo(q0.z); x[5] = bfhi(q0.z); x[6] = bflo(q0.w); x[7] = bfhi(q0.w);
    x[8] = bflo(q1.x); x[9] = bfhi(q1.x); x[10] = bflo(q1.y); x[11] = bfhi(q1.y); x[12] = bflo(q1.z); x[13] = bfhi(q1.z); x[14] = bflo(q1.w); x[15] = bfhi(q1.w);
}
__device__ __forceinline__ float wave_sum(float v) {
#pragma unroll
    for (int o = 1; o < 64; o <<= 1) v += __shfl_xor(v, o);
    return v;
}

#define XB_TMO      128
#define XB_XCNT(j)  (256  + 64 * (j))
#define XB_XSUB(j)  (1280 + 64 * (j))
#define XB_XGEN(j)  (2304 + 64 * (j))
#define XB_TOP      3328
#define XB_TOPGEN   3392
#define XCD_BAR_WORDS 3456
#define XB_SPIN_CAP (1u << 18)
__device__ __forceinline__ unsigned xb_ld(unsigned* p)              { return __hip_atomic_load(p, __ATOMIC_RELAXED, __HIP_MEMORY_SCOPE_AGENT); }
__device__ __forceinline__ unsigned xb_add(unsigned* p, unsigned v) { return __hip_atomic_fetch_add(p, v, __ATOMIC_RELAXED, __HIP_MEMORY_SCOPE_AGENT); }
__device__ __forceinline__ unsigned xb_xcc_id() { return (unsigned)__builtin_amdgcn_s_getreg((3 << 11) | 20) & 0xFu; }
#define XB_SPIN(cond, bar) do { unsigned _sp = 0; while (cond) { __builtin_amdgcn_s_sleep(1); \
    if ((++_sp & 255u) == 0u) { if (xb_ld(&(bar)[XB_TMO])) break; if (_sp > XB_SPIN_CAP) { atomicAdd(&(bar)[XB_TMO], 1u); break; } } } } while (0)
struct XcdBarrier { unsigned* bar; unsigned x; volatile LAS unsigned* st; };
__device__ __forceinline__ XcdBarrier xcd_barrier_post(unsigned* bar, volatile LAS unsigned* st) {
    XcdBarrier b; b.bar = bar; b.x = xb_xcc_id(); b.st = st;
    if (threadIdx.x == 0) (void)xb_add(&bar[XB_XCNT(b.x)], 1u);
    return b;
}
__device__ __forceinline__ void xcd_barrier_complete(unsigned* bar, unsigned x, unsigned& nloc, unsigned& nx) {
    const unsigned G = gridDim.x * gridDim.y * gridDim.z;
    unsigned sum, cnt, mine, sp = 0u;
    for (;;) {
        sum = 0u; cnt = 0u; mine = 0u;
#pragma unroll
        for (unsigned j = 0; j < 16; ++j) { const unsigned c = xb_ld(&bar[XB_XCNT(j)]); sum += c; cnt += (c > 0u) ? 1u : 0u; mine = (j == x) ? c : mine; }
        if (sum == G) break;
        __builtin_amdgcn_s_sleep(1);
        if ((++sp & 255u) == 0u) { if (xb_ld(&bar[XB_TMO])) break; if (sp > XB_SPIN_CAP) { atomicAdd(&bar[XB_TMO], 1u); break; } }
    }
    nloc = mine > 0u ? mine : 1u; nx = cnt > 0u ? cnt : 1u;
}
__device__ __forceinline__ void xcd_barrier(const XcdBarrier& b) {
    asm volatile("s_waitcnt vmcnt(0)" ::: "memory");
    __syncthreads();
    if (threadIdx.x == 0) {
        unsigned* bar = b.bar;
        __builtin_amdgcn_s_waitcnt(0);
        unsigned nloc = b.st[0], nx = b.st[1];
        if (nloc == 0u) { xcd_barrier_complete(bar, b.x, nloc, nx); b.st[0] = nloc; b.st[1] = nx; }
        const unsigned old = xb_add(&bar[XB_XSUB(b.x)], 1u);
        const unsigned gen = old / nloc;
        if (old + 1u == (gen + 1u) * nloc) {
            __builtin_amdgcn_fence(__ATOMIC_RELEASE, "agent");
            asm volatile("s_waitcnt vmcnt(0)" ::: "memory");
            const unsigned og = xb_add(&bar[XB_TOP], 1u);
            const unsigned tg = og / nx;
            if (og + 1u == (tg + 1u) * nx) xb_add(&bar[XB_TOPGEN], 1u);
            else XB_SPIN(xb_ld(&bar[XB_TOPGEN]) == tg, bar);
            __builtin_amdgcn_fence(__ATOMIC_ACQUIRE, "agent");
            xb_add(&bar[XB_XGEN(b.x)], 1u);
            asm volatile("s_waitcnt vmcnt(0)" ::: "memory");
        } else {
            XB_SPIN(xb_ld(&bar[XB_XGEN(b.x)]) == gen, bar);
            __builtin_amdgcn_fence(__ATOMIC_ACQUIRE, "agent");
            asm volatile("s_waitcnt vmcnt(0)" ::: "memory");
        }
    }
    __syncthreads();
}

struct Args { const float* in[20]; float* out; unsigned char* ws; int ph_lo, ph_hi; };
enum { I_X = 0, I_MIXN, I_WIN, I_LNW, I_LNB, I_WSP, I_BSP, I_GON, I_LBF, I_LBB, I_HON, I_WOUT, I_MOEN, I_WR, I_BR, I_W1, I_B1, I_W2, I_B2, I_FIN };

struct Frame {
    LAS unsigned char* lds;
    int tid, lane, wave, G, gw, NGW;
};

__device__ __forceinline__ void p0_transpose_item(const float* W, int K, int N, bf16* WT, LAS float* scr, int item, int lane) {
    const int nblk = N / 32, kb = item / nblk, nb = item % nblk, k0 = 64 * kb, n0 = 32 * nb;
#pragma unroll 8
    for (int i = 0; i < 32; ++i) { const int kk = 2 * i + (lane >> 5); scr[kk * 33 + (lane & 31)] = W[(size_t)(k0 + kk) * N + n0 + (lane & 31)]; }
    LDS_WAIT(); asm volatile("" ::: "memory");
    const int c = lane & 7;
#pragma unroll
    for (int j = 0; j < 4; ++j) { const int n = (lane >> 3) + 8 * j; const LAS float* s = scr + (8 * c) * 33 + n;
        v4u o; o.x = pk2(s[0 * 33], s[1 * 33]); o.y = pk2(s[2 * 33], s[3 * 33]); o.z = pk2(s[4 * 33], s[5 * 33]); o.w = pk2(s[6 * 33], s[7 * 33]);
        *(GAS v4u*)(WT + (size_t)(n0 + n) * K + k0 + 8 * c) = o; }
    LDS_WAIT(); asm volatile("" ::: "memory");
}
template <bool PERMW1>
__device__ __forceinline__ void p0_block_tile_fp8(const float* W, int K, int N, unsigned char* WT, LAS float* scr, int tile, int tid) {
    const int nblk = N / 256, kb = tile / nblk, nb = tile % nblk, k0 = 128 * kb, n0 = 256 * nb;
    const int r = tid >> 6, nq = tid & 63;
#pragma unroll
    for (int i = 0; i < 16; ++i) { const int kk = 8 * i + r; const f32x4 v = *(const GAS f32x4*)(W + (size_t)(k0 + kk) * N + n0 + 4 * nq);
        *(LAS f32x4*)(scr + kk * 260 + 16 * (kk >> 6) + 4 * nq) = v; }
    LBAR();
    { const int n = tid >> 1, ch = tid & 1; const LAS float* s = scr + (64 * ch) * 260 + 16 * ch + n;
      const int ng = n0 + n; const int drow = PERMW1 ? ((ng >> 8) * 256 + (ng & 1) * 128 + ((ng & 255) >> 1)) : ng;
      GAS v4u* dst = (GAS v4u*)(WT + (size_t)drow * K + k0 + 64 * ch);
#pragma unroll
      for (int q = 0; q < 4; ++q) { float f[16];
#pragma unroll
          for (int i = 0; i < 16; ++i) f[i] = s[(16 * q + i) * 260] * pg8::W8_SCALE;
          v4u o; o.x = pg8::cvt4_fp8(f[0], f[1], f[2], f[3]); o.y = pg8::cvt4_fp8(f[4], f[5], f[6], f[7]); o.z = pg8::cvt4_fp8(f[8], f[9], f[10], f[11]); o.w = pg8::cvt4_fp8(f[12], f[13], f[14], f[15]);
          dst[q] = o; } }
    LBAR();
}
constexpr int P0_TILE_BYTES = (128 * 260 + 16) * 4;
struct P0Tile { const float* W; unsigned char* WT; int K, N, k0, n0; bool perm; };
__device__ __forceinline__ void rms_row_to_bf16(const float* xrow, const float* w, bf16* orow, int lane) {
    const GAS f32x4* xr = (const GAS f32x4*)xrow + lane; const GAS f32x4* wr = (const GAS f32x4*)w + lane;
    f32x4 v[8]; float s = 0.f;
#pragma unroll
    for (int j = 0; j < 8; ++j) { v[j] = xr[64 * j]; s += (v[j].x * v[j].x + v[j].y * v[j].y) + (v[j].z * v[j].z + v[j].w * v[j].w); }
    const float r = 1.0f / sqrtf(wave_sum(s) * (1.f / DM) + EPS);
    GAS v2u* o8 = (GAS v2u*)orow + lane;
#pragma unroll
    for (int j = 0; j < 8; ++j) { const f32x4 g = wr[64 * j]; v2u o; o.x = pk2(v[j].x * r * g.x, v[j].y * r * g.y); o.y = pk2(v[j].z * r * g.z, v[j].w * r * g.w); o8[64 * j] = o; }
}
constexpr int P0_T_E1 = (DM / 128) * (4096 / 256), P0_T_E2 = (DEXP / 128) * (DM / 256);
constexpr int P0_NTILES = NEXP * P0_T_E1 + NEXP * P0_T_E2;
constexpr int P0_LATE_TILES = 896;
constexpr int P1_GEMM_WGS = 180, P1_CONV_PER_WG = 132;
constexpr int P1_CONV_TILES = (256 - P1_GEMM_WGS) * P1_CONV_PER_WG;
constexpr int P7_TAIL_TILES = P0_NTILES - P0_LATE_TILES - P1_CONV_TILES;
static_assert(P1_CONV_TILES + P0_LATE_TILES >= NEXP * P0_T_E1 && P7_TAIL_TILES % 2 == 0 && P7_TAIL_TILES >= 0, "the GEMM1-tail tiles must be W2 tiles");
__device__ __forceinline__ P0Tile p0_tile_decode(const Args& a, int r) {
    P0Tile t;
    if (r < NEXP * P0_T_E1) { const int e = r / P0_T_E1, q = r % P0_T_E1; t.W = a.in[I_W1] + (size_t)e * DM * 4096; t.WT = a.ws + WS_W1T + (size_t)e * 4096 * DM; t.K = DM; t.N = 4096; t.k0 = 128 * (q / 16); t.n0 = 256 * (q % 16); t.perm = true; }
    else { const int p = r - NEXP * P0_T_E1; const int e = p / P0_T_E2, q = p % P0_T_E2; t.W = a.in[I_W2] + (size_t)e * DEXP * DM; t.WT = a.ws + WS_W2T + (size_t)e * DM * DEXP; t.K = DEXP; t.N = DM; t.k0 = 128 * (q / 8); t.n0 = 256 * (q % 8); t.perm = false; }
    return t;
}
__device__ __forceinline__ void cv_issue(const Frame& F, const Args& a, int it, int qq, int slot) {
    const P0Tile t = p0_tile_decode(a, it);
    LAS unsigned char* dst = F.lds + slot * 32768;
#pragma unroll
    for (int j = 0; j < 4; ++j) { const int kq = F.wave + 8 * j;
        const float* src = t.W + (size_t)(t.k0 + 4 * kq + (F.lane >> 4)) * t.N + t.n0 + 64 * qq + 4 * ((F.lane & 15) ^ (kq >> 2));
        __builtin_amdgcn_global_load_lds((const unsigned*)src, (LAS unsigned*)(dst + kq * 1024), 16, 0, 2); }
}
__device__ __forceinline__ void cv_convert(const Frame& F, const Args& a, int it, int qq, int slot) {
    const P0Tile t = p0_tile_decode(a, it);
    const int kg = F.lane & 7, n = 8 * F.wave + (F.lane >> 3);
    const LAS float* src = (const LAS float*)(F.lds + slot * 32768 + (16 * kg) * 256 + 16 * ((n >> 2) ^ kg) + 4 * (n & 3));
    float f[16];
#pragma unroll
    for (int i = 0; i < 16; ++i) f[i] = src[i * 64] * pg8::W8_SCALE;
    const int nl = 64 * qq + n;
    const int drow = t.n0 + (t.perm ? ((nl & 1) * 128 + (nl >> 1)) : nl);
    v4u o; o.x = pg8::cvt4_fp8(f[0], f[1], f[2], f[3]); o.y = pg8::cvt4_fp8(f[4], f[5], f[6], f[7]); o.z = pg8::cvt4_fp8(f[8], f[9], f[10], f[11]); o.w = pg8::cvt4_fp8(f[12], f[13], f[14], f[15]);
    __builtin_nontemporal_store(o, (GAS v4u*)(t.WT + (size_t)drow * t.K + t.k0 + 16 * kg));
}
__device__ __forceinline__ void p0_expert_tiles(const Frame& F, const Args& a, int first, int stride, int lo, int hi) {
    const int t0 = lo + first;
    if (t0 >= hi) return;
    const int Q = 4 * ((hi - t0 + stride - 1) / stride);
#define CV_G(g) ((g) < Q ? (g) : Q - 1)
#define CV_TILE(g) (t0 + (CV_G(g) >> 2) * stride)
#define CV_QQ(g) (CV_G(g) & 3)
    cv_issue(F, a, CV_TILE(0), CV_QQ(0), 0); cv_issue(F, a, CV_TILE(1), CV_QQ(1), 1); cv_issue(F, a, CV_TILE(2), CV_QQ(2), 2);
    for (int g = 0; g < Q; ++g) {
        if (g >= 3) asm volatile("s_waitcnt vmcnt(11)" ::: "memory"); else if (g == 2) asm volatile("s_waitcnt vmcnt(10)" ::: "memory");
        else if (g == 1) asm volatile("s_waitcnt vmcnt(9)" ::: "memory"); else asm volatile("s_waitcnt vmcnt(8)" ::: "memory");
        __builtin_amdgcn_s_barrier(); asm volatile("" ::: "memory");
        cv_issue(F, a, CV_TILE(g + 3), CV_QQ(g + 3), (g + 3) & 3);
        cv_convert(F, a, CV_TILE(g), CV_QQ(g), g & 3);
    }
    asm volatile("s_waitcnt vmcnt(0)" ::: "memory"); __builtin_amdgcn_s_barrier(); asm volatile("" ::: "memory");
#undef CV_G
#undef CV_TILE
#undef CV_QQ
}
__device__ __forceinline__ void p0_expert_tiles_blk(const Frame& F, const Args& a, int first, int stride, int lo, int hi) {
    const float* W1 = a.in[I_W1]; const float* W2 = a.in[I_W2]; unsigned char* W1T = a.ws + WS_W1T; unsigned char* W2T = a.ws + WS_W2T;
    LAS float* scr = (LAS float*)F.lds;
    for (int it = lo + first; it < hi; it += stride) {
        int r = it;
        if (r < NEXP * P0_T_E1) { const int e = r / P0_T_E1; p0_block_tile_fp8<true>(W1 + (size_t)e * DM * 4096, DM, 4096, W1T + (size_t)e * 4096 * DM, scr, r % P0_T_E1, F.tid); continue; } r -= NEXP * P0_T_E1;
        { const int e = r / P0_T_E2; p0_block_tile_fp8<false>(W2 + (size_t)e * DEXP * DM, DEXP, DM, W2T + (size_t)e * DM * DEXP, scr, r % P0_T_E2, F.tid); }
    }
}
__device__ __forceinline__ void p0_prologue(const Frame& F, const Args& a) {
    const float* Win = a.in[I_WIN]; const float* Wout = a.in[I_WOUT]; const float* W1 = a.in[I_W1]; const float* W2 = a.in[I_W2];
    bf16* WinT = (bf16*)(a.ws + WS_WIN_T); bf16* WoutT = (bf16*)(a.ws + WS_WOUT_T); unsigned char* W1T = a.ws + WS_W1T; unsigned char* W2T = a.ws + WS_W2T;
    p0_expert_tiles_blk(F, a, blockIdx.x, F.G, 0, F.G == 256 ? 0 : P1_CONV_TILES);
    { LAS float* scr = (LAS float*)(F.lds + F.wave * 16384);
      constexpr int I_IN = (DM / 64) * (INC / 32), I_OUT = (DM / 64) * (DM / 32);
      const int r8 = F.lane >> 3, c8 = F.lane & 7;
      f32x4 v[8]; bf16* dcur = WinT;
#define P0_TR_DECODE(it_, src_, n_, dst_) do { int _i = (it_); if (_i < I_IN) { const int kb = _i / (INC / 32), nb = _i % (INC / 32); src_ = Win + (size_t)(64 * kb) * INC + 32 * nb; n_ = INC; dst_ = WinT + (size_t)(32 * nb) * DM + 64 * kb; } \
          else { _i -= I_IN; const int kb = _i / (DM / 32), nb = _i % (DM / 32); src_ = Wout + (size_t)(64 * kb) * DM + 32 * nb; n_ = DM; dst_ = WoutT + (size_t)(32 * nb) * DM + 64 * kb; } } while (0)
#define P0_TR_LOAD(src_, n_) do { _Pragma("unroll") for (int i = 0; i < 8; ++i) v[i] = *(const GAS f32x4*)((src_) + (size_t)(8 * i + r8) * (n_) + 4 * c8); } while (0)
      int it = F.gw;
      if (it < I_IN + I_OUT) { const float* src; int n; P0_TR_DECODE(it, src, n, dcur); P0_TR_LOAD(src, n); }
      for (; it < I_IN + I_OUT; it += F.NGW) {
#pragma unroll
          for (int i = 0; i < 8; ++i) { LAS float* d = scr + (8 * i + r8) * 33 + 4 * c8; d[0] = v[i].x; d[1] = v[i].y; d[2] = v[i].z; d[3] = v[i].w; }
          LDS_WAIT(); asm volatile("" ::: "memory");
          bf16* dst = dcur;
          if (it + F.NGW < I_IN + I_OUT) { const float* src; int n; P0_TR_DECODE(it + F.NGW, src, n, dcur); P0_TR_LOAD(src, n); }
#pragma unroll
          for (int j = 0; j < 4; ++j) { const int n = r8 + 8 * j; const LAS float* sp = scr + (8 * c8) * 33 + n;
              v4u o; o.x = pk2(sp[0 * 33], sp[1 * 33]); o.y = pk2(sp[2 * 33], sp[3 * 33]); o.z = pk2(sp[4 * 33], sp[5 * 33]); o.w = pk2(sp[6 * 33], sp[7 * 33]);
              *(GAS v4u*)(dst + (size_t)n * DM + 8 * c8) = o; }
          LDS_WAIT(); asm volatile("" ::: "memory");
      }
#undef P0_TR_DECODE
#undef P0_TR_LOAD
    }
    { float* WRT = (float*)(a.ws + WS_WRT); const float* Wr = a.in[I_WR];
      for (int i = blockIdx.x * NTHREADS + F.tid; i < DM * NEXP; i += F.G * NTHREADS) { const int e = i / DM, d = i % DM; WRT[i] = Wr[(size_t)d * NEXP + e]; } }
    bf16* H = (bf16*)(a.ws + WS_H);
    for (int m = F.gw; m < NTOK; m += F.NGW) rms_row_to_bf16(a.in[I_X] + (size_t)m * DM, a.in[I_MIXN], H + (size_t)m * DM, F.lane);
}

typedef short s16x8 __attribute__((ext_vector_type(8)));
constexpr int VT_STRIDE = 272;
constexpr int VT_BYTES = 128 * VT_STRIDE;
__device__ __forceinline__ void gmlp_stage_vt(const Frame& F, const Args& a, int row0, int h, LAS unsigned char* VT, const LAS float* st) {
    const bf16* Z = (const bf16*)(a.ws + WS_Z);
    const int dg = F.tid >> 5, sg = F.tid & 31;
    const float* lw = a.in[I_LNW] + h * 128 + 8 * dg; const float* lb = a.in[I_LNB] + h * 128 + 8 * dg;
    float w8[8], b8[8];
#pragma unroll
    for (int j = 0; j < 8; ++j) { w8[j] = lw[j]; b8[j] = lb[j]; }
    float x[4][8];
#pragma unroll
    for (int i = 0; i < 4; ++i) { const int s = 4 * sg + i; const v4u q = *(const GAS v4u*)(Z + (size_t)(row0 + s) * INC + ZV + h * 128 + 8 * dg); const float mu = st[s], rs = st[128 + s];
        const unsigned w[4] = {q.x, q.y, q.z, q.w};
#pragma unroll
        for (int j = 0; j < 4; ++j) { x[i][2 * j] = (bflo(w[j]) - mu) * rs * w8[2 * j] + b8[2 * j]; x[i][2 * j + 1] = (bfhi(w[j]) - mu) * rs * w8[2 * j + 1] + b8[2 * j + 1]; } }
#pragma unroll
    for (int j = 0; j < 8; ++j) { v2u o; o.x = pk2(x[0][j], x[1][j]); o.y = pk2(x[2][j], x[3][j]); *(LAS v2u*)(VT + (8 * dg + j) * VT_STRIDE + 8 * sg) = o; }
}
__device__ __forceinline__ void gmlp_item_mfma(const Frame& F, const Args& a, int item) {
    const bf16* Z = (const bf16*)(a.ws + WS_Z); bf16* CAT = (bf16*)(a.ws + WS_CAT); float* SSQ = (float*)(a.ws + WS_ARAW);
    LAS unsigned char* VT0 = F.lds + RING_OFF;
    LAS float* st = (LAS float*)(F.lds + SMALL_OFF);
    const int hh = item & 1, row0 = (item >> 1) * 128, fr = F.lane & 15, fq = F.lane >> 4;
#pragma unroll 1
    for (int rb = 0; rb < 4; ++rb) { v4u q[4][2];
#pragma unroll
        for (int r = 0; r < 4; ++r) { const GAS v4u* vp = (const GAS v4u*)(Z + (size_t)(row0 + 16 * F.wave + 4 * rb + r) * INC + ZV + 16 * F.lane); q[r][0] = vp[0]; q[r][1] = vp[1]; }
#pragma unroll
        for (int r = 0; r < 4; ++r) { float x[16]; unpack16(q[r][0], q[r][1], x); float sm = 0.f;
#pragma unroll
            for (int i = 0; i < 16; ++i) sm += x[i];
            const float mu = wave_sum(sm) * (1.f / DA); float qq = 0.f;
#pragma unroll
            for (int i = 0; i < 16; ++i) { const float d = x[i] - mu; qq += d * d; }
            const float rstd = 1.0f / sqrtf(wave_sum(qq) * (1.f / DA) + EPS);
            if (F.lane == 0) { st[16 * F.wave + 4 * rb + r] = mu; st[128 + 16 * F.wave + 4 * rb + r] = rstd; } } }
    __syncthreads();
    gmlp_stage_vt(F, a, row0, 4 * hh, VT0, st);
    LBAR();
    const int t = 16 * F.wave + fr;
    float ssq = 0.f;
    for (int hi = 0; hi < 4; ++hi) { const int h = 4 * hh + hi;
        LAS unsigned char* VT = VT0 + (hi & 1) * VT_BYTES;
        s16x8 af[4];
        { const GAS f32x4* wp = (const GAS f32x4*)(a.in[I_WSP] + (size_t)h * 16384 + (size_t)t * 128 + 8 * fq);
#pragma unroll
          for (int ks = 0; ks < 4; ++ks) { const f32x4 p = wp[8 * ks], q = wp[8 * ks + 1];
              const v4u pk = {pk2(p.x, p.y), pk2(p.z, p.w), pk2(q.x, q.y), pk2(q.z, q.w)}; af[ks] = __builtin_bit_cast(s16x8, pk); } }
        v2u uq[8];
#pragma unroll
        for (int nt = 0; nt < 8; ++nt) uq[nt] = *(const GAS v2u*)(Z + (size_t)(row0 + t) * INC + ZU + h * 128 + 16 * nt + 4 * fq);
        const float bsv = a.in[I_BSP][h * 128 + t];
        if (hi + 1 < 4) gmlp_stage_vt(F, a, row0, h + 1, VT0 + ((hi + 1) & 1) * VT_BYTES, st);
        f32x4 acc[8];
#pragma unroll
        for (int nt = 0; nt < 8; ++nt) acc[nt] = (f32x4){0.f, 0.f, 0.f, 0.f};
#pragma unroll
        for (int ks = 0; ks < 4; ++ks)
#pragma unroll
            for (int nt = 0; nt < 8; ++nt) { const s16x8 bfr = *(const LAS s16x8*)(VT + (16 * nt + fr) * VT_STRIDE + (32 * ks + 8 * fq) * 2);
                acc[nt] = __builtin_amdgcn_mfma_f32_16x16x32_bf16(bfr, af[ks], acc[nt], 0, 0, 0); }
#pragma unroll
        for (int nt = 0; nt < 8; ++nt) { const int d0 = 16 * nt + 4 * fq;
            const float a0 = bflo(uq[nt].x) * (acc[nt][0] + bsv), a1 = bfhi(uq[nt].x) * (acc[nt][1] + bsv), a2 = bflo(uq[nt].y) * (acc[nt][2] + bsv), a3 = bfhi(uq[nt].y) * (acc[nt][3] + bsv);
            ssq += (a0 * a0 + a1 * a1) + (a2 * a2 + a3 * a3);
            v2u o; o.x = pk2(a0, a1); o.y = pk2(a2, a3); *(GAS v2u*)(CAT + (size_t)(row0 + t) * DM + h * 128 + d0) = o; }
        LBAR();
    }
    ssq += __shfl_xor(ssq, 16); ssq += __shfl_xor(ssq, 32);
    if (fq == 0) SSQ[(size_t)hh * NTOK + row0 + t] = ssq;
}

constexpr int HG_SS = 144;
constexpr int HG_QD = 0, HG_KD = 9216, HG_KT = 18432, HG_IT = 27648, HG_SC = 46080, HG_DEC = 55296, HG_GS = 55552, HG_PAR = 57600;
constexpr int HG_ST0 = 2 * HG_PAR, HG_ST1 = HG_ST0 + 18432, HG_END = HG_ST1 + 18432;
static_assert(HG_END <= MISC_OFF, "hgrn LDS map");
__device__ __forceinline__ void hgrn_item_mfma(const Frame& F, const Args& a, int item) {
    const char* Zb = (const char*)(a.ws + WS_Z);
    const int b = item >> 5, h = (item >> 2) & 7, dir = (item >> 1) & 1, kh = item & 1;
    char* Ob = (char*)(a.ws + (dir ? WS_OB : WS_OF)) + (size_t)kh * NTOK * DA * 2;
    LAS unsigned char* L = F.lds;
    const int fr = F.lane & 15, fq = F.lane >> 4, w = F.wave, lane = F.lane;
    const int kp = lane & 31, hf = lane >> 5, tg = 2 * w + hf;
    const float* tab = dir ? a.in[I_LBB] : a.in[I_LBF];
    float lb0, lb1;
    { const int kc = h * 128 + 64 * kh + 2 * kp; const float t0 = tab[kc], t1 = tab[1024 + kc]; lb0 = 1.0f / (1.0f + expf(t1 - t0));
      const float u0 = tab[kc + 1], u1 = tab[1024 + kc + 1]; lb1 = 1.0f / (1.0f + expf(u1 - u0)); }
    const float om0 = 1.0f - lb0, om1 = 1.0f - lb1;
    unsigned offz[4], offi[8];
#pragma unroll
    for (int i = 0; i < 4; ++i) { const int j = 4 * tg + i, jr = dir ? 63 - j : j; offz[i] = (unsigned)(jr * INC + h * 128 + 64 * kh + 2 * kp) * 2u; }
#pragma unroll
    for (int i = 0; i < 8; ++i) { const int j = 8 * w + i, jr = dir ? 63 - j : j; offi[i] = (unsigned)(jr * INC + h * 128 + ZI + 2 * lane) * 2u; }
    const unsigned zfo = (unsigned)(dir ? ZFB : ZFF) * 2u, zqo = (unsigned)ZQ * 2u;
    unsigned offo; { const int j = 16 * (w >> 1) + fr, jr = dir ? 63 - j : j; offo = (unsigned)(jr * DA + h * 128 + 64 * (w & 1) + 4 * fq) * 2u; }
    for (int i = F.tid; i < 18432 / 4; i += NTHREADS) ((LAS unsigned*)(L + HG_ST0))[i] = 0u;
    f32x4 S[4];
#pragma unroll
    for (int vj = 0; vj < 4; ++vj) S[vj] = (f32x4){0.f, 0.f, 0.f, 0.f};
    unsigned zq[4], qq[4], iq[8];
    float cum0[4], cum1[4], kk0[4], kk1[4], o0 = 0.f, o1 = 0.f;
#define HG_BLOCK(n) ((size_t)(b * SEQ + (dir ? (SEQ - 64 - (n) * 64) : ((n) * 64))))
#define HG_LOAD_ZI(n) do { const char* zc = Zb + HG_BLOCK(n) * (size_t)(INC * 2); \
        _Pragma("unroll") for (int i = 0; i < 4; ++i) zq[i] = *(const GAS unsigned*)(zc + zfo + offz[i]); \
        _Pragma("unroll") for (int i = 0; i < 8; ++i) iq[i] = *(const GAS unsigned*)(zc + offi[i]); } while (0)
#define HG_LOAD_Q(n) do { const char* zc = Zb + HG_BLOCK(n) * (size_t)(INC * 2); \
        _Pragma("unroll") for (int i = 0; i < 4; ++i) qq[i] = *(const GAS unsigned*)(zc + zqo + offz[i]); } while (0)
#define HG_A1(c) do { LAS unsigned char* P = L + ((c) & 1) * HG_PAR; float c0 = 0.f, c1 = 0.f; \
        _Pragma("unroll") for (int i = 0; i < 4; ++i) { const float z0 = bflo(zq[i]), z1 = bfhi(zq[i]); \
            const float s0 = __builtin_amdgcn_rcpf(1.0f + __builtin_amdgcn_exp2f(-1.44269504089f * z0)), s1 = __builtin_amdgcn_rcpf(1.0f + __builtin_amdgcn_exp2f(-1.44269504089f * z1)); \
            const float f0 = lb0 + om0 * s0, f1 = lb1 + om1 * s1; \
            kk0[i] = om0 - om0 * s0; kk1[i] = om1 - om1 * s1; \
            c0 += __builtin_amdgcn_logf(f0); c1 += __builtin_amdgcn_logf(f1); cum0[i] = c0; cum1[i] = c1; } \
        o0 = __shfl_xor(c0, 32); o1 = __shfl_xor(c1, 32); \
        if (hf == 0) *(LAS f32x2t*)(P + HG_GS + (w * 64 + 2 * kp) * 4) = (f32x2t){c0 + o0, c1 + o1}; \
        { v4u q0, q1; \
          q0.x = (iq[0] & 0xffffu) | (iq[1] << 16); q0.y = (iq[2] & 0xffffu) | (iq[3] << 16); q0.z = (iq[4] & 0xffffu) | (iq[5] << 16); q0.w = (iq[6] & 0xffffu) | (iq[7] << 16); \
          q1.x = (iq[0] >> 16) | (iq[1] & 0xffff0000u); q1.y = (iq[2] >> 16) | (iq[3] & 0xffff0000u); q1.z = (iq[4] >> 16) | (iq[5] & 0xffff0000u); q1.w = (iq[6] >> 16) | (iq[7] & 0xffff0000u); \
          *(LAS v4u*)(P + HG_IT + (2 * lane) * HG_SS + 16 * w) = q0; *(LAS v4u*)(P + HG_IT + (2 * lane + 1) * HG_SS + 16 * w) = q1; } } while (0)
#define HG_A2(c) do { LAS unsigned char* P = L + ((c) & 1) * HG_PAR; float off0 = hf ? o0 : 0.f, off1 = hf ? o1 : 0.f, tot0 = 0.f, tot1 = 0.f; \
        _Pragma("unroll") for (int g = 0; g < 8; ++g) { const f32x2t gs = *(const LAS f32x2t*)(P + HG_GS + (g * 64 + 2 * kp) * 4); if (g < w) { off0 += gs.x; off1 += gs.y; } tot0 += gs.x; tot1 += gs.y; } \
        const float dec0 = __builtin_amdgcn_exp2f(tot0), dec1 = __builtin_amdgcn_exp2f(tot1); \
        if (tg == 0) *(LAS f32x2t*)(P + HG_DEC + 8 * kp) = (f32x2t){dec0, dec1}; \
        float kt0[4], kt1[4]; \
        _Pragma("unroll") for (int i = 0; i < 4; ++i) { const float e0 = __builtin_amdgcn_exp2f(cum0[i] + off0), e1 = __builtin_amdgcn_exp2f(cum1[i] + off1); \
            const float kd0 = kk0[i] * __builtin_amdgcn_rcpf(e0), kd1 = kk1[i] * __builtin_amdgcn_rcpf(e1); \
            *(LAS unsigned*)(P + HG_QD + (4 * tg + i) * HG_SS + 4 * kp) = pk2(bflo(qq[i]) * e0, bfhi(qq[i]) * e1); \
            *(LAS unsigned*)(P + HG_KD + (4 * tg + i) * HG_SS + 4 * kp) = pk2(kd0, kd1); \
            kt0[i] = kd0 * dec0; kt1[i] = kd1 * dec1; } \
        *(LAS v2u*)(P + HG_KT + (2 * kp) * HG_SS + 8 * tg) = (v2u){pk2(kt0[0], kt0[1]), pk2(kt0[2], kt0[3])}; \
        *(LAS v2u*)(P + HG_KT + (2 * kp + 1) * HG_SS + 8 * tg) = (v2u){pk2(kt1[0], kt1[1]), pk2(kt1[2], kt1[3])}; } while (0)
    HG_LOAD_ZI(0); HG_LOAD_Q(0);
    LBAR();
    HG_A1(0);
    HG_LOAD_ZI(1);
    LBAR();
    HG_A2(0);
    HG_LOAD_Q(1);
    LBAR();
    for (int n = 0; n < SEQ / 64; ++n) {
        LAS unsigned char* P = L + (n & 1) * HG_PAR;
        LAS unsigned char* STc = L + ((n & 1) ? HG_ST1 : HG_ST0); LAS unsigned char* STn = L + ((n & 1) ? HG_ST0 : HG_ST1);
        { const int ti = w >> 1;
#pragma unroll
          for (int sj = 0; sj < 2; ++sj) { const int si = 2 * (w & 1) + sj; f32x4 acc = (f32x4){0.f, 0.f, 0.f, 0.f};
              if (si <= ti) {
#pragma unroll
                  for (int ks = 0; ks < 2; ++ks) { const s16x8 kf = *(const LAS s16x8*)(P + HG_KD + (16 * si + fr) * HG_SS + (32 * ks + 8 * fq) * 2), qf = *(const LAS s16x8*)(P + HG_QD + (16 * ti + fr) * HG_SS + (32 * ks + 8 * fq) * 2);
                      acc = __builtin_amdgcn_mfma_f32_16x16x32_bf16(kf, qf, acc, 0, 0, 0); } }
              const int t = 16 * ti + fr, s0 = 16 * si + 4 * fq;
              v2u o; o.x = pk2(s0 <= t ? acc[0] : 0.f, s0 + 1 <= t ? acc[1] : 0.f); o.y = pk2(s0 + 2 <= t ? acc[2] : 0.f, s0 + 3 <= t ? acc[3] : 0.f);
              *(LAS v2u*)(P + HG_SC + t * HG_SS + s0 * 2) = o; } }
        if (n + 1 < SEQ / 64) { HG_A1(n + 1); if (n + 2 < SEQ / 64) HG_LOAD_ZI(n + 2); }
        LBAR();
        if (n + 1 < SEQ / 64) { HG_A2(n + 1); if (n + 2 < SEQ / 64) HG_LOAD_Q(n + 2); }
        { const int ti = w >> 1;
          char* oc = Ob + HG_BLOCK(n) * (size_t)(DA * 2) + offo;
          s16x8 scf[2], qf[2];
#pragma unroll
          for (int ks = 0; ks < 2; ++ks) { scf[ks] = *(const LAS s16x8*)(P + HG_SC + (16 * ti + fr) * HG_SS + (32 * ks + 8 * fq) * 2); qf[ks] = *(const LAS s16x8*)(P + HG_QD + (16 * ti + fr) * HG_SS + (32 * ks + 8 * fq) * 2); }
#pragma unroll
          for (int vj = 0; vj < 4; ++vj) { const int vi = 4 * (w & 1) + vj; f32x4 acc = (f32x4){0.f, 0.f, 0.f, 0.f};
#pragma unroll
              for (int ks = 0; ks < 2; ++ks) { const s16x8 itf = *(const LAS s16x8*)(P + HG_IT + (16 * vi + fr) * HG_SS + (32 * ks + 8 * fq) * 2);
                  acc = __builtin_amdgcn_mfma_f32_16x16x32_bf16(itf, scf[ks], acc, 0, 0, 0); }
#pragma unroll
              for (int ks = 0; ks < 2; ++ks) { const s16x8 stf = *(const LAS s16x8*)(STc + (16 * vi + fr) * HG_SS + (32 * ks + 8 * fq) * 2);
                  acc = __builtin_amdgcn_mfma_f32_16x16x32_bf16(stf, qf[ks], acc, 0, 0, 0); }
              v2u o; o.x = pk2(acc[0], acc[1]); o.y = pk2(acc[2], acc[3]);
              *(GAS v2u*)(oc + 32 * vj) = o; } }
        { const int kt = w & 3;
          const f32x4 dc = *(const LAS f32x4*)(P + HG_DEC + (16 * kt + 4 * fq) * 4);
          s16x8 ktf[2];
#pragma unroll
          for (int ks = 0; ks < 2; ++ks) ktf[ks] = *(const LAS s16x8*)(P + HG_KT + (16 * kt + fr) * HG_SS + (32 * ks + 8 * fq) * 2);
#pragma unroll
          for (int vj = 0; vj < 4; ++vj) { const int vi = 4 * (w >> 2) + vj; S[vj] = S[vj] * dc;
#pragma unroll
              for (int ks = 0; ks < 2; ++ks) { const s16x8 itf = *(const LAS s16x8*)(P + HG_IT + (16 * vi + fr) * HG_SS + (32 * ks + 8 * fq) * 2);
                  S[vj] = __builtin_amdgcn_mfma_f32_16x16x32_bf16(ktf[ks], itf, S[vj], 0, 0, 0); }
              v2u o; o.x = pk2(S[vj][0], S[vj][1]); o.y = pk2(S[vj][2], S[vj][3]);
              *(LAS v2u*)(STn + (16 * vi + fr) * HG_SS + (16 * kt + 4 * fq) * 2) = o; } }
        LBAR();
    }
#undef HG_BLOCK
#undef HG_LOAD_ZI
#undef HG_LOAD_Q
#undef HG_A1
#undef HG_A2
}

constexpr int HF_QS = 272, HF_SS = 144;
constexpr int HF_QD = 0, HF_KD = 17408, HF_KT = 34816, HF_IT = 53248, HF_SC = 71680, HF_ST0 = 80896, HF_ST1 = 115712, HF_GS = 150528, HF_DEC = 154624, HF_END = 155136;
static_assert(HF_END <= MISC_OFF, "hgrn (full k) LDS map");
__device__ __forceinline__ void hgrn_full_item(const Frame& F, const Args& a, int item) {
    const char* Zb = (const char*)(a.ws + WS_Z);
    const int b = item >> 4, h = (item >> 1) & 7, dir = item & 1;
    char* Ob = (char*)(a.ws + (dir ? WS_OB : WS_OF));
    LAS unsigned char* L = F.lds;
    const int fr = F.lane & 15, fq = F.lane >> 4, w = F.wave, lane = F.lane;
    const float* tab = dir ? a.in[I_LBB] : a.in[I_LBF];
    float lb0, lb1;
    { const int kc = h * 128 + 2 * lane; const float t0 = tab[kc], t1 = tab[1024 + kc]; lb0 = 1.0f / (1.0f + expf(t1 - t0));
      const float u0 = tab[kc + 1], u1 = tab[1024 + kc + 1]; lb1 = 1.0f / (1.0f + expf(u1 - u0)); }
    const float om0 = 1.0f - lb0, om1 = 1.0f - lb1;
    unsigned offr[8];
#pragma unroll
    for (int i = 0; i < 8; ++i) { const int j = 8 * w + i, jr = dir ? 63 - j : j; offr[i] = (unsigned)(jr * INC + h * 128 + 2 * lane) * 2u; }
    const unsigned zfo = (unsigned)(dir ? ZFB : ZFF) * 2u, zqo = (unsigned)ZQ * 2u, zio = (unsigned)ZI * 2u;
    unsigned offo; { const int j = 16 * (w >> 1) + fr, jr = dir ? 63 - j : j; offo = (unsigned)(jr * DA + h * 128 + 64 * (w & 1) + 4 * fq) * 2u; }
    for (int i = F.tid; i < 34816 / 4; i += NTHREADS) ((LAS unsigned*)(L + HF_ST0))[i] = 0u;
    f32x4 S[8];
#pragma unroll
    for (int vi = 0; vi < 8; ++vi) S[vi] = (f32x4){0.f, 0.f, 0.f, 0.f};
    unsigned zq[8], qq[8], iq[8];
#define HF_BLOCK(n) ((size_t)(b * SEQ + (dir ? (SEQ - 64 - (n) * 64) : ((n) * 64))))
#define HF_LOAD(n) do { const char* zc = Zb + HF_BLOCK(n) * (size_t)(INC * 2); \
        _Pragma("unroll") for (int i = 0; i < 8; ++i) { zq[i] = *(const GAS unsigned*)(zc + zfo + offr[i]); qq[i] = *(const GAS unsigned*)(zc + zqo + offr[i]); iq[i] = *(const GAS unsigned*)(zc + zio + offr[i]); } } while (0)
    HF_LOAD(0);
    LBAR();
    for (int n = 0; n < SEQ / 64; ++n) {
        LAS unsigned char* STc = L + ((n & 1) ? HF_ST1 : HF_ST0); LAS unsigned char* STn = L + ((n & 1) ? HF_ST0 : HF_ST1);
        float cum0[8], cum1[8], kk0[8], kk1[8]; float c0 = 0.f, c1 = 0.f;
#pragma unroll
        for (int i = 0; i < 8; ++i) { const float z0 = bflo(zq[i]), z1 = bfhi(zq[i]);
            const float s0 = __builtin_amdgcn_rcpf(1.0f + __builtin_amdgcn_exp2f(-1.44269504089f * z0)), s1 = __builtin_amdgcn_rcpf(1.0f + __builtin_amdgcn_exp2f(-1.44269504089f * z1));
            const float f0 = lb0 + om0 * s0, f1 = lb1 + om1 * s1;
            kk0[i] = om0 - om0 * s0; kk1[i] = om1 - om1 * s1;
            c0 += __builtin_amdgcn_logf(f0); c1 += __builtin_amdgcn_logf(f1); cum0[i] = c0; cum1[i] = c1; }
        *(LAS f32x2t*)(L + HF_GS + (w * 128 + 2 * lane) * 4) = (f32x2t){c0, c1};
        { v4u q0, q1;
          q0.x = (iq[0] & 0xffffu) | (iq[1] << 16); q0.y = (iq[2] & 0xffffu) | (iq[3] << 16); q0.z = (iq[4] & 0xffffu) | (iq[5] << 16); q0.w = (iq[6] & 0xffffu) | (iq[7] << 16);
          q1.x = (iq[0] >> 16) | (iq[1] & 0xffff0000u); q1.y = (iq[2] >> 16) | (iq[3] & 0xffff0000u); q1.z = (iq[4] >> 16) | (iq[5] & 0xffff0000u); q1.w = (iq[6] >> 16) | (iq[7] & 0xffff0000u);
          *(LAS v4u*)(L + HF_IT + (2 * lane) * HF_SS + 16 * w) = q0; *(LAS v4u*)(L + HF_IT + (2 * lane + 1) * HF_SS + 16 * w) = q1; }
        LBAR();
        { float off0 = 0.f, off1 = 0.f, tot0 = 0.f, tot1 = 0.f;
#pragma unroll
          for (int g = 0; g < 8; ++g) { const f32x2t gs = *(const LAS f32x2t*)(L + HF_GS + (g * 128 + 2 * lane) * 4); if (g < w) { off0 += gs.x; off1 += gs.y; } tot0 += gs.x; tot1 += gs.y; }
          const float dec0 = __builtin_amdgcn_exp2f(tot0), dec1 = __builtin_amdgcn_exp2f(tot1);
          if (w == 0) *(LAS f32x2t*)(L + HF_DEC + 8 * lane) = (f32x2t){dec0, dec1};
          float kt0[8], kt1[8];
#pragma unroll
          for (int i = 0; i < 8; ++i) { const float e0 = __builtin_amdgcn_exp2f(cum0[i] + off0), e1 = __builtin_amdgcn_exp2f(cum1[i] + off1);
              const float kd0 = kk0[i] * __builtin_amdgcn_rcpf(e0), kd1 = kk1[i] * __builtin_amdgcn_rcpf(e1);
              *(LAS unsigned*)(L + HF_QD + (8 * w + i) * HF_QS + 4 * lane) = pk2(bflo(qq[i]) * e0, bfhi(qq[i]) * e1);
              *(LAS unsigned*)(L + HF_KD + (8 * w + i) * HF_QS + 4 * lane) = pk2(kd0, kd1);
              kt0[i] = kd0 * dec0; kt1[i] = kd1 * dec1; }
          *(LAS v4u*)(L + HF_KT + (2 * lane) * HF_SS + 16 * w) = (v4u){pk2(kt0[0], kt0[1]), pk2(kt0[2], kt0[3]), pk2(kt0[4], kt0[5]), pk2(kt0[6], kt0[7])};
          *(LAS v4u*)(L + HF_KT + (2 * lane + 1) * HF_SS + 16 * w) = (v4u){pk2(kt1[0], kt1[1]), pk2(kt1[2], kt1[3]), pk2(kt1[4], kt1[5]), pk2(kt1[6], kt1[7])}; }
        if (n + 1 < SEQ / 64) HF_LOAD(n + 1);
        LBAR();
        { const int ti = w >> 1;
#pragma unroll
          for (int sj = 0; sj < 2; ++sj) { const int si = 2 * (w & 1) + sj; f32x4 acc = (f32x4){0.f, 0.f, 0.f, 0.f};
              if (si <= ti) {
#pragma unroll
                  for (int ks = 0; ks < 4; ++ks) { const s16x8 kf = *(const LAS s16x8*)(L + HF_KD + (16 * si + fr) * HF_QS + (32 * ks + 8 * fq) * 2), qf = *(const LAS s16x8*)(L + HF_QD + (16 * ti + fr) * HF_QS + (32 * ks + 8 * fq) * 2);
                      acc = __builtin_amdgcn_mfma_f32_16x16x32_bf16(kf, qf, acc, 0, 0, 0); } }
              const int t = 16 * ti + fr, s0 = 16 * si + 4 * fq;
              v2u o; o.x = pk2(s0 <= t ? acc[0] : 0.f, s0 + 1 <= t ? acc[1] : 0.f); o.y = pk2(s0 + 2 <= t ? acc[2] : 0.f, s0 + 3 <= t ? acc[3] : 0.f);
              *(LAS v2u*)(L + HF_SC + t * HF_SS + s0 * 2) = o; } }
        LBAR();
        { const int ti = w >> 1;
          char* oc = Ob + HF_BLOCK(n) * (size_t)(DA * 2) + offo;
          s16x8 scf[2], qf[4];
#pragma unroll
          for (int ks = 0; ks < 2; ++ks) scf[ks] = *(const LAS s16x8*)(L + HF_SC + (16 * ti + fr) * HF_SS + (32 * ks + 8 * fq) * 2);
#pragma unroll
          for (int ks = 0; ks < 4; ++ks) qf[ks] = *(const LAS s16x8*)(L + HF_QD + (16 * ti + fr) * HF_QS + (32 * ks + 8 * fq) * 2);
#pragma unroll
          for (int vj = 0; vj < 4; ++vj) { const int vi = 4 * (w & 1) + vj; f32x4 acc = (f32x4){0.f, 0.f, 0.f, 0.f};
#pragma unroll
              for (int ks = 0; ks < 2; ++ks) { const s16x8 itf = *(const LAS s16x8*)(L + HF_IT + (16 * vi + fr) * HF_SS + (32 * ks + 8 * fq) * 2);
                  acc = __builtin_amdgcn_mfma_f32_16x16x32_bf16(itf, scf[ks], acc, 0, 0, 0); }
#pragma unroll
              for (int ks = 0; ks < 4; ++ks) { const s16x8 stf = *(const LAS s16x8*)(STc + (16 * vi + fr) * HF_QS + (32 * ks + 8 * fq) * 2);
                  acc = __builtin_amdgcn_mfma_f32_16x16x32_bf16(stf, qf[ks], acc, 0, 0, 0); }
              v2u o; o.x = pk2(acc[0], acc[1]); o.y = pk2(acc[2], acc[3]);
              *(GAS v2u*)(oc + 32 * vj) = o; } }
        { const f32x4 dc = *(const LAS f32x4*)(L + HF_DEC + (16 * w + 4 * fq) * 4);
          s16x8 ktf[2];
#pragma unroll
          for (int ks = 0; ks < 2; ++ks) ktf[ks] = *(const LAS s16x8*)(L + HF_KT + (16 * w + fr) * HF_SS + (32 * ks + 8 * fq) * 2);
#pragma unroll
          for (int vi = 0; vi < 8; ++vi) { S[vi] = S[vi] * dc;
#pragma unroll
              for (int ks = 0; ks < 2; ++ks) { const s16x8 itf = *(const LAS s16x8*)(L + HF_IT + (16 * vi + fr) * HF_SS + (32 * ks + 8 * fq) * 2);
                  S[vi] = __builtin_amdgcn_mfma_f32_16x16x32_bf16(ktf[ks], itf, S[vi], 0, 0, 0); }
              v2u o; o.x = pk2(S[vi][0], S[vi][1]); o.y = pk2(S[vi][2], S[vi][3]);
              *(LAS v2u*)(STn + (16 * vi + fr) * HF_QS + (16 * w + 4 * fq) * 2) = o; } }
        LBAR();
    }
#undef HF_BLOCK
#undef HF_LOAD
}

__device__ __forceinline__ void gmlp_full_item(const Frame& F, const Args& a, int item) {
    gmlp_item_mfma(F, a, 2 * item);
    __syncthreads();
    gmlp_item_mfma(F, a, 2 * item + 1);
    VM_WAIT();
    __syncthreads();
    bf16* CAT = (bf16*)(a.ws + WS_CAT); const float* SSQ = (const float*)(a.ws + WS_ARAW);
    LAS float* rs = (LAS float*)(F.lds + SMALL_OFF) + 256;
    const int row0 = item * 128;
    if (F.tid < 128) rs[F.tid] = 1.0f / sqrtf((SSQ[row0 + F.tid] + SSQ[NTOK + row0 + F.tid]) * (1.f / DA) + EPS);
    __syncthreads();
    { const int cg = F.tid & 127, rg = F.tid >> 7;
      const float* gp = a.in[I_GON] + 8 * cg; float g8[8];
#pragma unroll
      for (int j = 0; j < 8; ++j) g8[j] = gp[j];
#pragma unroll 8
      for (int i = 0; i < 32; ++i) { const int r = rg + 4 * i; const float sc = rs[r];
          GAS v4u* p = (GAS v4u*)(CAT + (size_t)(row0 + r) * DM + 8 * cg); const v4u q = *p;
          v4u o; o.x = pk2(bflo(q.x) * sc * g8[0], bfhi(q.x) * sc * g8[1]); o.y = pk2(bflo(q.y) * sc * g8[2], bfhi(q.y) * sc * g8[3]);
          o.z = pk2(bflo(q.z) * sc * g8[4], bfhi(q.z) * sc * g8[5]); o.w = pk2(bflo(q.w) * sc * g8[6], bfhi(q.w) * sc * g8[7]);
          *p = o; } }
    __syncthreads();
}

__device__ __forceinline__ void p3_cat(const Frame& F, const Args& a) {
    const bf16* Z = (const bf16*)(a.ws + WS_Z);
    const bf16* OF = (const bf16*)(a.ws + WS_OF); const bf16* OB = (const bf16*)(a.ws + WS_OB); bf16* CAT = (bf16*)(a.ws + WS_CAT);
    const float* hon = a.in[I_HON] + (F.lane & 7) * 16;
    float hn[16];
#pragma unroll
    for (int i = 0; i < 16; ++i) hn[i] = hon[i];
    for (int m0 = F.gw; m0 < NTOK; m0 += 2 * F.NGW) {
        const int m1 = m0 + F.NGW; const bool has1 = m1 < NTOK; const int mb = has1 ? m1 : m0;
        const GAS v4u* gpa = (const GAS v4u*)(Z + (size_t)m0 * INC + ZG + 16 * F.lane); const GAS v4u* fpa = (const GAS v4u*)(OF + (size_t)m0 * DA + 16 * F.lane); const GAS v4u* bpa = (const GAS v4u*)(OB + (size_t)m0 * DA + 16 * F.lane);
        const GAS v4u* gpb = (const GAS v4u*)(Z + (size_t)mb * INC + ZG + 16 * F.lane); const GAS v4u* fpb = (const GAS v4u*)(OF + (size_t)mb * DA + 16 * F.lane); const GAS v4u* bpb = (const GAS v4u*)(OB + (size_t)mb * DA + 16 * F.lane);
        const v4u ga0 = gpa[0], ga1 = gpa[1], fa0 = fpa[0], fa1 = fpa[1], ba0 = bpa[0], ba1 = bpa[1];
        const v4u gb0 = gpb[0], gb1 = gpb[1], fb0 = fpb[0], fb1 = fpb[1], bb0 = bpb[0], bb1 = bpb[1];
#pragma unroll
        for (int t = 0; t < 2; ++t) {
            if (t == 1 && !has1) break;
            float x[16], g[16], p0[16], p1[16];
            if (t == 0) { unpack16(ga0, ga1, g); unpack16(fa0, fa1, p0); unpack16(ba0, ba1, p1); } else { unpack16(gb0, gb1, g); unpack16(fb0, fb1, p0); unpack16(bb0, bb1, p1); }
            float ss = 0.f;
#pragma unroll
            for (int i = 0; i < 16; ++i) { x[i] = p0[i] + p1[i]; ss += x[i] * x[i]; }
            ss += __shfl_xor(ss, 1); ss += __shfl_xor(ss, 2); ss += __shfl_xor(ss, 4);
            const float rh = 1.0f / sqrtf(ss * (1.f / 128.f) + EPS);
#pragma unroll
            for (int i = 0; i < 16; ++i) x[i] = x[i] * rh * hn[i] * g[i];
            v4u o0, o1;
            o0.x = pk2(x[0], x[1]); o0.y = pk2(x[2], x[3]); o0.z = pk2(x[4], x[5]); o0.w = pk2(x[6], x[7]);
            o1.x = pk2(x[8], x[9]); o1.y = pk2(x[10], x[11]); o1.z = pk2(x[12], x[13]); o1.w = pk2(x[14], x[15]);
            GAS v4u* cp = (GAS v4u*)(CAT + (size_t)(t ? m1 : m0) * DM + DA + 16 * F.lane); cp[0] = o0; cp[1] = o1;
        }
    }
}

__device__ __forceinline__ float rt_dot16(const f32x4 (&x)[4], const f32x4 (&w)[4]) {
    f32x2t s = (f32x2t){x[0].x, x[0].y} * (f32x2t){w[0].x, w[0].y};
    s += (f32x2t){x[0].z, x[0].w} * (f32x2t){w[0].z, w[0].w};
#pragma unroll
    for (int j = 1; j < 4; ++j) { s += (f32x2t){x[j].x, x[j].y} * (f32x2t){w[j].x, w[j].y}; s += (f32x2t){x[j].z, x[j].w} * (f32x2t){w[j].z, w[j].w}; }
    return s.x + s.y;
}
__device__ __forceinline__ void p5_route(const Frame& F, const Args& a) {
    const float* X = a.in[I_X]; const bf16* DL = (const bf16*)(a.ws + WS_X1); unsigned char* H2 = a.ws + WS_H; const float* WRT = (const float*)(a.ws + WS_WRT);
    bf16* X1B = (bf16*)(a.ws + WS_OF);
    unsigned* ctl = (unsigned*)(a.ws + WS_CTL);
    int* tok_e = (int*)(a.ws + WS_ROUTE + RT_TOKE); int* tok_pos = (int*)(a.ws + WS_ROUTE + RT_TOKPOS);
    int* list = (int*)(a.ws + WS_ROUTE + RT_LIST); float* listg = (float*)(a.ws + WS_ROUTE + RT_LISTG);
    LAS float* WL = (LAS float*)(F.lds + RING_OFF);
    LAS int* hist = (LAS int*)(F.lds + SMALL_OFF);
    LAS int* base = hist + 32;
    LAS int* asg_e = hist + 64;
    LAS int* asg_rank = hist + 64 + 256;
    LAS float* asg_gate = (LAS float*)(hist + 64 + 512);
    LAS float* lg = (LAS float*)(hist + 64 + 768);
    const float* mn = a.in[I_MOEN]; const float* br = a.in[I_BR];
    const int lane = F.lane, b5 = (lane >> 5) & 1, b4 = (lane >> 4) & 1, b3 = (lane >> 3) & 1, myt = 4 * b5 + 2 * b4 + b3;
    for (int chunk = blockIdx.x; chunk < NTOK / 64; chunk += F.G) {
        if (F.tid < 32) hist[F.tid] = 0;
        const int m0 = chunk * 64 + 8 * F.wave;
        float rsl = 0.f;
#pragma unroll
        for (int tk = 0; tk < 8; ++tk) { const int m = m0 + tk; const GAS f32x4* xr = (const GAS f32x4*)(X + (size_t)m * DM) + lane; const GAS v2u* dr = (const GAS v2u*)(DL + (size_t)m * DM) + lane; f32x4 v[8]; float ss = 0.f;
#pragma unroll
            for (int j = 0; j < 8; ++j) { const v2u d = dr[64 * j]; v[j] = xr[64 * j]; v[j].x += bflo(d.x); v[j].y += bfhi(d.x); v[j].z += bflo(d.y); v[j].w += bfhi(d.y); ss += (v[j].x * v[j].x + v[j].y * v[j].y) + (v[j].z * v[j].z + v[j].w * v[j].w); }
            const float r = 1.0f / sqrtf(wave_sum(ss) * (1.f / DM) + EPS);
            rsl = (tk == myt) ? r : rsl;
            { GAS v2u* xb = (GAS v2u*)(X1B + (size_t)m * DM) + lane;
#pragma unroll
              for (int j = 0; j < 8; ++j) { v2u o; o.x = pk2(v[j].x, v[j].y); o.y = pk2(v[j].z, v[j].w); __builtin_nontemporal_store(o, xb + 64 * j); } }
            GAS unsigned* o8 = (GAS unsigned*)(H2 + (size_t)m * DM) + lane;
#pragma unroll
            for (int j = 0; j < 8; ++j) { const f32x4 g = ((const GAS f32x4*)mn)[lane + 64 * j]; o8[64 * j] = pg8::cvt4_fp8(v[j].x * r * g.x, v[j].y * r * g.y, v[j].z * r * g.z, v[j].w * r * g.w); } }
        for (int hh = 0; hh < 2; ++hh) {
            __syncthreads();
#pragma unroll 4
            for (int j = 0; j < 16; ++j) { const int idx4 = F.tid + 512 * j, e = idx4 >> 8, kq = idx4 & 255;
                const f32x4 w = *(const GAS f32x4*)(WRT + (size_t)e * DM + 1024 * hh + 4 * kq), g = *(const GAS f32x4*)(mn + 1024 * hh + 4 * kq);
                *(LAS f32x4*)(WL + e * 1024 + 4 * kq) = w * g; }
            asm volatile("" ::: "memory");
            __syncthreads();
#pragma unroll 1
            for (int grp = 0; grp < 2; ++grp) {
                f32x4 xv[4][4];
#pragma unroll
                for (int tk = 0; tk < 4; ++tk) { const int m = m0 + 4 * grp + tk; const GAS f32x4* xr = (const GAS f32x4*)(X + (size_t)m * DM + 1024 * hh) + lane; const GAS v2u* dr = (const GAS v2u*)(DL + (size_t)m * DM + 1024 * hh) + lane;
#pragma unroll
                    for (int j = 0; j < 4; ++j) { const v2u d = dr[64 * j]; f32x4 v = xr[64 * j]; v.x += bflo(d.x); v.y += bfhi(d.x); v.z += bflo(d.y); v.w += bfhi(d.y); xv[tk][j] = v; } }
#pragma unroll 1
                for (int eb = 0; eb < 32; eb += 8) {
                    float p[8][4];
#pragma unroll
                    for (int e8 = 0; e8 < 8; ++e8) { f32x4 w[4];
#pragma unroll
                        for (int j = 0; j < 4; ++j) w[j] = *(const LAS f32x4*)(WL + (eb + e8) * 1024 + 4 * lane + 256 * j);
#pragma unroll
                        for (int tk = 0; tk < 4; ++tk) p[e8][tk] = rt_dot16(xv[tk], w); }
                    float q[8][2], t1[8];
#pragma unroll
                    for (int e8 = 0; e8 < 8; ++e8)
#pragma unroll
                        for (int i = 0; i < 2; ++i) { const float send = b5 ? p[e8][i] : p[e8][i + 2], keep = b5 ? p[e8][i + 2] : p[e8][i]; q[e8][i] = keep + __shfl_xor(send, 32); }
#pragma unroll
                    for (int e8 = 0; e8 < 8; ++e8) { const float send = b4 ? q[e8][0] : q[e8][1], keep = b4 ? q[e8][1] : q[e8][0]; t1[e8] = keep + __shfl_xor(send, 16); }
#pragma unroll
                    for (int e8 = 0; e8 < 8; ++e8) t1[e8] += __shfl_xor(t1[e8], 8);
#pragma unroll
                    for (int e8 = 0; e8 < 8; ++e8) t1[e8] += __shfl_xor(t1[e8], 4);
#pragma unroll
                    for (int e8 = 0; e8 < 8; ++e8) t1[e8] += __shfl_xor(t1[e8], 2);
#pragma unroll
                    for (int e8 = 0; e8 < 8; ++e8) t1[e8] += __shfl_xor(t1[e8], 1);
                    if ((lane & 15) == 0) { LAS float* lp = lg + (8 * F.wave + 4 * grp + 2 * b5 + b4) * 33 + eb;
#pragma unroll
                        for (int e8 = 0; e8 < 8; ++e8) lp[e8] = hh ? (lp[e8] + t1[e8]) : t1[e8]; }
                }
            }
        }
        LDS_WAIT();
        if ((lane & 7) == 0) {
            float l[32];
#pragma unroll
            for (int e = 0; e < 32; ++e) l[e] = lg[(8 * F.wave + myt) * 33 + e] * rsl + br[e];
            int sel[4]; float val[4];
#pragma unroll
            for (int j = 0; j < 4; ++j) { float best = -3.0e38f; int bi = 0;
#pragma unroll
                for (int e = 0; e < 32; ++e) { if (l[e] > best) { best = l[e]; bi = e; } }
                sel[j] = bi; val[j] = best;
#pragma unroll
                for (int e = 0; e < 32; ++e) l[e] = (e == bi) ? -3.0e38f : l[e]; }
            const float e1 = expf(val[1] - val[0]), e2 = expf(val[2] - val[0]), e3 = expf(val[3] - val[0]); const float inv = 1.0f / (1.0f + e1 + e2 + e3);
            const float gt[4] = {inv, e1 * inv, e2 * inv, e3 * inv};
#pragma unroll
            for (int j = 0; j < 4; ++j) { const int slot = (8 * F.wave + myt) * 4 + j; const int rk = atomicAdd((int*)&hist[sel[j]], 1); asg_e[slot] = sel[j]; asg_rank[slot] = rk; asg_gate[slot] = gt[j]; }
        }
        __syncthreads();
        if (F.tid < 32) base[F.tid] = (int)atomicAdd(&ctl[CW_CNT + 64 * F.tid], (unsigned)hist[F.tid]);
        __syncthreads();
        if (F.tid < 256) { const int tok = chunk * 64 + (F.tid >> 2), j = F.tid & 3; const int e = asg_e[F.tid], pos = base[e] + asg_rank[F.tid];
            list[(size_t)e * CAP + pos] = tok; listg[(size_t)e * CAP + pos] = asg_gate[F.tid]; tok_e[tok * 4 + j] = e; tok_pos[tok * 4 + j] = pos; }
        __syncthreads();
    }
}

__device__ __forceinline__ int build_tiles(const Frame& F, const Args& a) {
    unsigned* ctl = (unsigned*)(a.ws + WS_CTL);
    LAS int* cnt = (LAS int*)(F.lds + TILES_OFF); LAS int* tstart = cnt + 32; LAS unsigned char* tileE = (LAS unsigned char*)(tstart + 64);
    __syncthreads();
    if (F.tid < 64) { const int e = F.tid & 31; const int c = (int)__hip_atomic_load(&ctl[CW_CNT + 64 * e], __ATOMIC_RELAXED, __HIP_MEMORY_SCOPE_AGENT); const int nt = (c + 255) >> 8;
        int incl = nt;
#pragma unroll
        for (int o = 1; o < 32; o <<= 1) { const int v = __shfl_up(incl, o); if ((F.tid & 31) >= o) incl += v; }
        if (F.tid < 32) { cnt[e] = c; tstart[e] = incl - nt; if (e == 31) tstart[32] = incl;
            for (int t = incl - nt; t < incl; ++t) tileE[t] = (unsigned char)e; } }
    __syncthreads();
    return tstart[32];
}
#define TILE_CNT(F)    ((LAS int*)((F).lds + TILES_OFF))
#define TILE_START(F)  ((LAS int*)((F).lds + TILES_OFF) + 32)
#define TILE_E(F)      ((LAS unsigned char*)((LAS int*)((F).lds + TILES_OFF) + 96))

template <class Sched>
__device__ __forceinline__ void fill_tokidx(const Frame& F, const Args& a, const Sched& S) {
    const LAS int* cnt = TILE_CNT(F); const LAS int* tstart = TILE_START(F);
    const int* list = (const int*)(a.ws + WS_ROUTE + RT_LIST);
    LAS unsigned short* tk = (LAS unsigned short*)(F.lds + TOKIDX_OFF);
    pg8::Unit u;
    const int r = F.tid & 255;
    for (int i0 = F.tid >> 8; i0 < MAXU; i0 += 6) {
        int tokv[3]; bool ok[3], val[3];
#pragma unroll
        for (int k = 0; k < 3; ++k) { const int i = i0 + 2 * k; ok[k] = i < MAXU && S.next(i, u); size_t idx = 0; val[k] = false;
            if (ok[k]) { const int pos = (u.pm - tstart[u.e]) * 256 + r; val[k] = pos < cnt[u.e]; if (val[k]) idx = (size_t)u.e * CAP + pos; }
            tokv[k] = list[idx]; }
#pragma unroll
        for (int k = 0; k < 3; ++k) if (ok[k]) tk[(i0 + 2 * k) * 256 + r] = (unsigned short)(val[k] ? tokv[k] : 0);
        if (!ok[2]) break;
    }
    __syncthreads();
}

__device__ __forceinline__ void p8_final(const Frame& F, const Args& a, bool have_tiles) {
    if (!have_tiles) (void)build_tiles(F, a);
    const LAS int* tstart = TILE_START(F);
    const bf16* X1B = (const bf16*)(a.ws + WS_OF); const unsigned char* Y = a.ws + WS_Y;
    const int* tok_e = (const int*)(a.ws + WS_ROUTE + RT_TOKE); const int* tok_pos = (const int*)(a.ws + WS_ROUTE + RT_TOKPOS);
    const float* fn = a.in[I_FIN];
    f32x4 fg[8];
#pragma unroll
    for (int j = 0; j < 8; ++j) fg[j] = ((const GAS f32x4*)fn)[F.lane + 64 * j];
    for (int m0 = F.gw; m0 < NTOK; m0 += 2 * F.NGW) {
        const int m1r = m0 + F.NGW; const bool has1 = m1r < NTOK; const int m1 = has1 ? m1r : m0;
        v2u d0[8], d1[8]; unsigned q0[4][8], q1[4][8];
        { const GAS v2u* dr0 = (const GAS v2u*)(X1B + (size_t)m0 * DM) + F.lane; const GAS v2u* dr1 = (const GAS v2u*)(X1B + (size_t)m1 * DM) + F.lane;
#pragma unroll
          for (int j = 0; j < 8; ++j) { d0[j] = dr0[64 * j]; d1[j] = dr1[64 * j]; }
#pragma unroll
          for (int s = 0; s < 4; ++s) { const int e0 = tok_e[m0 * 4 + s], p0 = tok_pos[m0 * 4 + s], e1 = tok_e[m1 * 4 + s], p1 = tok_pos[m1 * 4 + s];
              const GAS unsigned* y0 = (const GAS unsigned*)(Y + ((size_t)tstart[e0] * 256 + p0) * DM) + F.lane; const GAS unsigned* y1 = (const GAS unsigned*)(Y + ((size_t)tstart[e1] * 256 + p1) * DM) + F.lane;
#pragma unroll
              for (int j = 0; j < 8; ++j) { q0[s][j] = y0[64 * j]; q1[s][j] = y1[64 * j]; } } }
#pragma unroll
        for (int t = 0; t < 2; ++t) {
            if (t == 1 && !has1) break;
            f32x4 v[8];
#pragma unroll
            for (int j = 0; j < 8; ++j) { const v2u d = t ? d1[j] : d0[j]; v[j] = (f32x4){bflo(d.x), bfhi(d.x), bflo(d.y), bfhi(d.y)}; }
#pragma unroll
            for (int s = 0; s < 4; ++s)
#pragma unroll
                for (int j = 0; j < 8; ++j) { const unsigned q = t ? q1[s][j] : q0[s][j]; const f32x2t lo = __builtin_amdgcn_cvt_pk_f32_fp8((int)q, false), hi = __builtin_amdgcn_cvt_pk_f32_fp8((int)q, true);
                    v[j].x += lo.x; v[j].y += lo.y; v[j].z += hi.x; v[j].w += hi.y; }
            float ss = 0.f;
#pragma unroll
            for (int j = 0; j < 8; ++j) ss += (v[j].x * v[j].x + v[j].y * v[j].y) + (v[j].z * v[j].z + v[j].w * v[j].w);
            const float r = 1.0f / sqrtf(wave_sum(ss) * (1.f / DM) + EPS);
            GAS f32x4* op = (GAS f32x4*)(a.out + (size_t)(t ? m1 : m0) * DM) + F.lane;
#pragma unroll
            for (int j = 0; j < 8; ++j) { const f32x4 g = fg[j]; f32x4 o; o.x = v[j].x * r * g.x; o.y = v[j].y * r * g.y; o.z = v[j].z * r * g.z; o.w = v[j].w * r * g.w; op[64 * j] = o; }
        }
    }
}

constexpr int N_PHASES = 10;
__device__ __forceinline__ Args load_args() {
#if defined(__HIP_DEVICE_COMPILE__)
    const __attribute__((address_space(4))) unsigned char* p = (const __attribute__((address_space(4))) unsigned char*)__builtin_amdgcn_kernarg_segment_ptr();
    asm volatile("" : "+s"(p));
    return *(const __attribute__((address_space(4))) Args*)p;
#else
    return Args{};
#endif
}
__global__ void __launch_bounds__(NTHREADS, 2) fwd_kernel(Args kargs_) {
    extern __shared__ __attribute__((aligned(16))) unsigned char lds_raw[];
    Frame F;
    F.lds = (LAS unsigned char*)lds_raw;
    F.tid = threadIdx.x; F.lane = F.tid & 63; F.wave = __builtin_amdgcn_readfirstlane(F.tid >> 6);
    F.G = gridDim.x; F.gw = blockIdx.x * NWAVES + F.wave; F.NGW = F.G * NWAVES;
    volatile LAS unsigned* MISC = (volatile LAS unsigned*)(F.lds + MISC_OFF);
    if (F.tid < 16) MISC[F.tid] = 0u;
    __syncthreads();
    unsigned* ctl; int lo, hi; { const Args args = load_args(); ctl = (unsigned*)(args.ws + WS_CTL); lo = args.ph_lo; hi = args.ph_hi; }
    const bool multi = (hi - lo) > 1;
    XcdBarrier bar; bar.bar = ctl + CW_BAR; bar.x = 0; bar.st = nullptr;
    if (multi) bar = xcd_barrier_post(ctl + CW_BAR, MISC + 8);
#ifndef PHMASK
#define PHMASK 0x3ff
#endif
#define IN(k) (((PHMASK >> (k)) & 1) && lo <= (k) && (k) < hi)
#ifndef REPMASK
#define REPMASK 0
#endif
#define REP(k) (((REPMASK >> (k)) & 1) ? 2 : 1)
#define SEAM(k) do { if (IN(k) && IN((k) + 1)) xcd_barrier(bar); } while (0)

    if (IN(0)) { const Args args = load_args(); p0_prologue(F, args); }
    SEAM(0);
    if (IN(1)) { const Args args = load_args(); {
        const int GG = (F.G == 256) ? P1_GEMM_WGS : F.G;
        if ((int)blockIdx.x < GG) {
        pg8::StaticOrder S; S.init(args.ws + WS_H, args.ws + WS_WIN_T, NTOK, INC, DM, GG, (int)blockIdx.x);
        pg8::EpiZ E{(pg8::bf16_t*)(args.ws + WS_Z), INC};
        pg8::gemm_phase<pg8::EpiZ, pg8::StaticOrder>(F.lds + RING_OFF, DM, S, E);
        } else p0_expert_tiles(F, args, (int)blockIdx.x - GG, F.G - GG, 0, P1_CONV_TILES);
    } }
    SEAM(1);
    if (IN(2)) { const Args args = load_args();
        for (int rep = 0; rep < REP(2); ++rep) { if (rep) xcd_barrier(bar);
        for (int it = blockIdx.x; it < 256; it += F.G) { if (it < 128) hgrn_full_item(F, args, it); else gmlp_full_item(F, args, it - 128); }
        { const int half = F.G / 2; if ((int)blockIdx.x >= half) { __syncthreads(); p0_expert_tiles(F, args, (int)blockIdx.x - half, F.G - half, P1_CONV_TILES, P1_CONV_TILES + P0_LATE_TILES); } } }
    }
    SEAM(2);
    if (IN(3)) { const Args args = load_args(); p3_cat(F, args); }
    SEAM(3);
    if (IN(4)) { const Args args = load_args(); {
        pg8::StaticOrder S; S.init(args.ws + WS_CAT, args.ws + WS_WOUT_T, NTOK, DM, DM, F.G, (int)blockIdx.x);
        pg8::EpiBf16Plain E{(pg8::bf16_t*)(args.ws + WS_X1), DM};
        pg8::gemm_phase<pg8::EpiBf16Plain, pg8::StaticOrder>(F.lds + RING_OFF, DM, S, E);
    } }
    SEAM(4);
    if (IN(5)) { const Args args = load_args(); p5_route(F, args); }
    do { if (IN(5) && IN(7)) xcd_barrier(bar); } while (0);
    if (IN(7)) { const Args args = load_args(); {
        const int NT = build_tiles(F, args);
        pg8::GroupedOrder S; S.init(args.ws + WS_H, args.ws + WS_W1T, DM / 2, 16, NT, TILE_E(F), F.G, (int)blockIdx.x);
        fill_tokidx(F, args, S);
        S.tokidx = (const LAS unsigned short*)(F.lds + TOKIDX_OFF);
        pg8::EpiSwiglu E{args.ws + WS_ACT, args.in[I_B1]};
        pg8::gemm_phase<pg8::EpiSwiglu, pg8::GroupedOrder, true, true>(F.lds + RING_OFF, DM / 2, S, E, F.lds + EBUF_OFF);
        for (;;) {
            __syncthreads();
            if (F.tid == 0) MISC[4] = __hip_atomic_fetch_add(&ctl[CW_TQ], 1u, __ATOMIC_RELAXED, __HIP_MEMORY_SCOPE_AGENT);
            __syncthreads();
            const int t = (int)MISC[4];
            if (t >= P7_TAIL_TILES) break;
            const int tl = P1_CONV_TILES + P0_LATE_TILES + t;
            p0_expert_tiles_blk(F, args, 0, 1, tl, tl + 1);
        }
    } }
    SEAM(7);
    if (IN(8)) { const Args args = load_args(); {
        const int NT = IN(7) ? TILE_START(F)[32] : build_tiles(F, args);
        pg8::GroupedOrder S; S.init(args.ws + WS_ACT, args.ws + WS_W2T, DEXP / 2, 8, NT, TILE_E(F), F.G, (int)blockIdx.x);
        S.pw = 8;
        pg8::EpiY E{args.ws + WS_Y, args.in[I_B2], (const float*)(args.ws + WS_ROUTE + RT_LISTG), TILE_START(F), CAP};
        pg8::gemm_phase<pg8::EpiY, pg8::GroupedOrder, true>(F.lds + RING_OFF, DEXP / 2, S, E, F.lds + EBUF_OFF);
        { const int rounds = (S.nU + F.G - 1) / F.G; pg8::Unit uu;
          const bool idle = (S.nU % F.G != 0) && !S.next(rounds - 1, uu);
          if (idle) {
          const GAS v4u* xb = (const GAS v4u*)(args.ws + WS_OF);
          for (int k = 0; k < 4; ++k) {
              __syncthreads();
              if (F.tid == 0) MISC[5] = __hip_atomic_fetch_add(&ctl[CW_PF], 1u, __ATOMIC_RELAXED, __HIP_MEMORY_SCOPE_AGENT);
              __syncthreads();
              const unsigned c = MISC[5];
              if (c >= 256u) break;
              const GAS v4u* p = xb + (size_t)c * 16384 + F.tid;
              unsigned acc = 0;
#pragma unroll
              for (int j = 0; j < 32; ++j) { const v4u v = p[512 * j]; acc ^= (v.x ^ v.y) ^ (v.z ^ v.w); }
              asm volatile("" :: "v"(acc));
          } } }
    } }
    SEAM(8);
    if (IN(9)) { const Args args = load_args(); p8_final(F, args, IN(7)); }
#undef IN
#undef SEAM
}

extern "C" void kernel_launch(void* const* d_in, const int* in_sizes, int n_in, void* d_out, int out_size, void* d_ws, size_t ws_size, hipStream_t stream) {
    static int grid = 0;
    if (grid == 0) {
        if (n_in != 20 || out_size != NTOK * DM || ws_size < WS_END) { fprintf(stderr, "kernel_launch: unexpected shapes (n_in %d out %d ws %zu)\n", n_in, out_size, ws_size); grid = -1; return; }
        int dev = 0, cus = 0, per_cu = 0;
        if (hipGetDevice(&dev) != hipSuccess || hipDeviceGetAttribute(&cus, hipDeviceAttributeMultiprocessorCount, dev) != hipSuccess) { grid = -1; return; }
        if (hipFuncSetAttribute((const void*)fwd_kernel, hipFuncAttributeMaxDynamicSharedMemorySize, LDS_BYTES) != hipSuccess) { fprintf(stderr, "kernel_launch: hipFuncSetAttribute failed\n"); grid = -1; return; }
        if (hipOccupancyMaxActiveBlocksPerMultiprocessor(&per_cu, (const void*)fwd_kernel, NTHREADS, LDS_BYTES) != hipSuccess || per_cu < 1) { fprintf(stderr, "kernel_launch: occupancy query says %d\n", per_cu); }
        (void)hipGetLastError();
        grid = cus;
    }
    if (grid < 0) return;
    (void)hipMemsetAsync((char*)d_ws + WS_CTL, 0, CTL_ZERO_BYTES, stream);
    Args a{};
    for (int i = 0; i < 20; ++i) a.in[i] = (const float*)d_in[i];
    a.out = (float*)d_out; a.ws = (unsigned char*)d_ws;
#if MK_N_LAUNCHES == 1
    a.ph_lo = 0; a.ph_hi = N_PHASES;
    hipLaunchKernelGGL(fwd_kernel, dim3(grid), dim3(NTHREADS), LDS_BYTES, stream, a);
#else
    for (int p = 0; p < N_PHASES; ++p) { a.ph_lo = p; a.ph_hi = p + 1; hipLaunchKernelGGL(fwd_kernel, dim3(grid), dim3(NTHREADS), LDS_BYTES, stream, a); }
#endif
}
```
